# Optimizing an MI355X kernel written in HIP

```python
import math
import jax, jax.numpy as jnp
from jax import lax
import numpy as np

D_MODEL = 2048
BATCH = 2
SEQ = 8192
DEPTH = 4

HEAD_DIM = 64
N_MIX_HEADS = D_MODEL // HEAD_DIM
A_HEADS = N_MIX_HEADS // 4
A_KV_HEADS = A_HEADS // 4
B_HEADS = N_MIX_HEADS // 4
C_HEADS = N_MIX_HEADS - A_HEADS - B_HEADS
C_KV_HEADS = C_HEADS // 4
A_W = A_HEADS * HEAD_DIM
A_KV_W = A_KV_HEADS * HEAD_DIM
B_W = B_HEADS * HEAD_DIM
C_W = C_HEADS * HEAD_DIM
C_KV_W = C_KV_HEADS * HEAD_DIM
MIX_WIDTH = A_W + B_W + C_W
IN_SIZES = [A_W, A_KV_W, A_KV_W, B_W, B_W, B_W, C_W, C_KV_W, C_KV_W]
IN_WIDTH = sum(IN_SIZES)
IN_SPLITS = [int(v) for v in np.cumsum(IN_SIZES)[:-1]]

WINDOW = 128
A_BLOCK = 128
T5_BUCKETS = 32
T5_MAX_DIST = 128
GRID_W = 64
NA_ROWS_MAX = 8
NA_COLS = 16
NA_QCOLS = 16
C_BLOCK = 128
ROPE_THETA = 10000.0
D_FF = 4 * D_MODEL
EPS = 1e-6
MASK_VALUE = -1e30

kernel_name = "hymba_style_hybrid_encoder"


def rmsnorm(x, g):
    xf = x.astype(jnp.float32)
    y = xf * lax.rsqrt(jnp.mean(xf * xf, axis=-1, keepdims=True) + EPS)
    return (y * g.astype(jnp.float32)).astype(x.dtype)


def t5_bucket(rel):
    nb = T5_BUCKETS // 2
    max_exact = nb // 2
    base = jnp.where(rel > 0, nb, 0)
    n = jnp.abs(rel)
    nf = jnp.maximum(n, 1).astype(jnp.float32)
    large = max_exact + (jnp.log(nf / max_exact) / math.log(T5_MAX_DIST / max_exact)
                         * (nb - max_exact)).astype(jnp.int32)
    large = jnp.minimum(large, nb - 1)
    return base + jnp.where(n < max_exact, n, large)


def window_attention(q, k, v, sink, t5_table):
    bsz, s_len = q.shape[0], q.shape[1]
    nb = s_len // A_BLOCK
    grp = A_HEADS // A_KV_HEADS
    qb = q.reshape(bsz, nb, A_BLOCK, A_KV_HEADS, grp, HEAD_DIM)

    def kv_blocks(t):
        tp = jnp.pad(t, ((0, 0), (A_BLOCK, A_BLOCK), (0, 0), (0, 0)))
        parts = [tp[:, o:o + s_len].reshape(bsz, nb, A_BLOCK, A_KV_HEADS, HEAD_DIM)
                 for o in (0, A_BLOCK, 2 * A_BLOCK)]
        return jnp.concatenate(parts, axis=2)

    kb, vb = kv_blocks(k), kv_blocks(v)
    qi = jnp.arange(A_BLOCK)[:, None]
    kj = jnp.arange(3 * A_BLOCK)[None, :]
    rel = kj - A_BLOCK - qi
    bias = t5_table[t5_bucket(rel)]
    bias = bias.transpose(2, 0, 1).reshape(A_KV_HEADS, grp, A_BLOCK, 3 * A_BLOCK).astype(jnp.float32)
    key_pos = jnp.arange(nb)[:, None] * A_BLOCK - A_BLOCK + jnp.arange(3 * A_BLOCK)[None, :]
    valid = ((jnp.abs(rel) <= WINDOW)[None]
             & ((key_pos >= 0) & (key_pos < s_len))[:, None, :])
    scale = HEAD_DIM ** -0.5
    s = jnp.einsum('bnqgrd,bnkgd->bngrqk', qb, kb).astype(jnp.float32) * scale + bias
    s = jnp.where(valid[None, :, None, None], s, MASK_VALUE)
    sink_l = jnp.broadcast_to(sink.astype(jnp.float32).reshape(1, 1, A_KV_HEADS, grp, 1, 1),
                              s.shape[:-1] + (1,))
    p = jax.nn.softmax(jnp.concatenate([s, sink_l], axis=-1), axis=-1)[..., :-1]
    o = jnp.einsum('bngrqk,bnkgd->bnqgrd', p.astype(v.dtype), vb)
    return o.reshape(bsz, s_len, A_W)


def neighborhood_attention(q, k, v, rpb):
    bsz, s_len = q.shape[0], q.shape[1]
    rows = s_len // GRID_W
    kr = min(NA_ROWS_MAX, rows)
    ncb = GRID_W // NA_QCOLS
    kbw = min(GRID_W, NA_COLS + NA_QCOLS)
    q5 = q.reshape(bsz, rows, GRID_W, B_HEADS, HEAD_DIM)
    k5 = k.reshape(bsz, rows, GRID_W, B_HEADS, HEAD_DIM)
    v5 = v.reshape(bsz, rows, GRID_W, B_HEADS, HEAD_DIM)
    r = jnp.arange(rows)
    row_start = jnp.clip(r - kr // 2, 0, rows - kr)
    row_idx = row_start[:, None] + jnp.arange(kr)[None, :]
    dr_idx = row_idx - r[:, None] + (NA_ROWS_MAX - 1)
    c = jnp.arange(GRID_W).reshape(ncb, NA_QCOLS)
    col_start = jnp.clip(c - NA_COLS // 2, 0, GRID_W - NA_COLS)
    kblk_start = jnp.clip(jnp.arange(ncb) * NA_QCOLS - NA_COLS // 2, 0, GRID_W - kbw)
    kcols = kblk_start[:, None] + jnp.arange(kbw)[None, :]
    kc = kcols[:, None, :]
    cs = col_start[:, :, None]
    col_valid = (kc >= cs) & (kc < cs + NA_COLS)
    dc_idx = jnp.clip(kc - c[:, :, None] + NA_COLS - 1, 0, 2 * NA_COLS - 2)
    scale = HEAD_DIM ** -0.5

    def row_block(args):
        q_r, ridx, dridx = args
        kg = k5[:, ridx][:, :, kcols]
        vg = v5[:, ridx][:, :, kcols]
        qg = q_r.reshape(bsz, ncb, NA_QCOLS, B_HEADS, HEAD_DIM)
        s = jnp.einsum('bmqhd,bimjhd->bmhqij', qg, kg).astype(jnp.float32) * scale
        bias = rpb[:, dridx][:, :, dc_idx]
        s = s + bias.transpose(2, 0, 3, 1, 4).astype(jnp.float32)[None]
        s = jnp.where(col_valid[None, :, None, :, None, :], s, MASK_VALUE)
        p = jax.nn.softmax(s.reshape(bsz, ncb, B_HEADS, NA_QCOLS, kr * kbw), axis=-1)
        p = p.reshape(s.shape).astype(v.dtype)
        o = jnp.einsum('bmhqij,bimjhd->bmqhd', p, vg)
        return o.reshape(bsz, GRID_W, B_HEADS, HEAD_DIM)

    o = lax.map(row_block, (q5.transpose(1, 0, 2, 3, 4), row_idx, dr_idx))
    return o.transpose(1, 0, 2, 3, 4).reshape(bsz, s_len, B_W)


def rope_axis(x, ang):
    x1, x2 = jnp.split(x, 2, axis=-1)
    cos = jnp.cos(ang)[None, :, None, :]
    sin = jnp.sin(ang)[None, :, None, :]
    return jnp.concatenate([x1 * cos - x2 * sin, x2 * cos + x1 * sin], axis=-1).astype(x.dtype)


def axial_rope(x, ang_row, ang_col):
    x_row, x_col = jnp.split(x, 2, axis=-1)
    return jnp.concatenate([rope_axis(x_row, ang_row), rope_axis(x_col, ang_col)], axis=-1)


def axial_global_attention(q, k, v, q_gain, k_gain):
    bsz, s_len = q.shape[0], q.shape[1]
    grp = C_HEADS // C_KV_HEADS
    t = jnp.arange(s_len)
    row = (t // GRID_W).astype(jnp.float32)
    col = (t % GRID_W).astype(jnp.float32)
    axis_dim = HEAD_DIM // 2
    freqs = ROPE_THETA ** (-jnp.arange(0, axis_dim, 2, dtype=jnp.float32) / axis_dim)
    ang_row = row[:, None] * freqs[None, :]
    ang_col = col[:, None] * freqs[None, :]
    q = axial_rope(rmsnorm(q, q_gain), ang_row, ang_col)
    k = axial_rope(rmsnorm(k, k_gain), ang_row, ang_col)
    nb = s_len // C_BLOCK
    qb = q.reshape(bsz, nb, C_BLOCK, C_KV_HEADS, grp, HEAD_DIM).transpose(1, 0, 2, 3, 4, 5)
    scale = HEAD_DIM ** -0.5

    def block(q_blk):
        s = jnp.einsum('bqgrd,bkgd->bgrqk', q_blk, k).astype(jnp.float32) * scale
        p = jax.nn.softmax(s, axis=-1).astype(v.dtype)
        return jnp.einsum('bgrqk,bkgd->bqgrd', p, v)

    o = lax.map(block, qb)
    return o.transpose(1, 0, 2, 3, 4, 5).reshape(bsz, s_len, C_W)


def setup_inputs(seed: int = 0) -> dict:
    key = jax.random.key(seed)
    ks = jax.random.split(key, 16)
    f32 = jnp.float32

    def nrm(k, shape, scale):
        return jax.random.normal(k, shape, f32) * scale

    return {
        "x": nrm(ks[0], (BATCH, SEQ, D_MODEL), 1.0),
        "norm_mix": 1.0 + nrm(ks[1], (DEPTH, D_MODEL), 0.02),
        "w_in": nrm(ks[2], (DEPTH, D_MODEL, IN_WIDTH), D_MODEL ** -0.5),
        "a_sink": nrm(ks[3], (DEPTH, A_HEADS), 0.5),
        "t5_table": nrm(ks[4], (T5_BUCKETS, A_HEADS), 0.5),
        "b_rpb": nrm(ks[5], (DEPTH, B_HEADS, 2 * NA_ROWS_MAX - 1, 2 * NA_COLS - 1), 0.5),
        "c_q_gain": 1.0 + nrm(ks[6], (DEPTH, HEAD_DIM), 0.02),
        "c_k_gain": 1.0 + nrm(ks[7], (DEPTH, HEAD_DIM), 0.02),
        "out_gain_a": 1.0 + nrm(ks[8], (DEPTH, A_W), 0.02),
        "out_gain_b": 1.0 + nrm(ks[9], (DEPTH, B_W), 0.02),
        "out_gain_c": 1.0 + nrm(ks[10], (DEPTH, C_W), 0.02),
        "w_o": nrm(ks[11], (DEPTH, MIX_WIDTH, D_MODEL), MIX_WIDTH ** -0.5),
        "norm_mlp": 1.0 + nrm(ks[12], (DEPTH, D_MODEL), 0.02),
        "w_up": nrm(ks[13], (DEPTH, D_MODEL, D_FF), D_MODEL ** -0.5),
        "w_down": nrm(ks[14], (DEPTH, D_FF, D_MODEL), D_FF ** -0.5),
        "norm_final": 1.0 + nrm(ks[15], (D_MODEL,), 0.02),
    }


def reference(x, norm_mix, w_in, a_sink, t5_table, b_rpb, c_q_gain, c_k_gain,
              out_gain_a, out_gain_b, out_gain_c, w_o, norm_mlp, w_up, w_down, norm_final):
    bsz, s_len = x.shape[0], x.shape[1]
    for l in range(DEPTH):
        h = rmsnorm(x, norm_mix[l])
        proj = jnp.einsum('bsd,de->bse', h, w_in[l])
        qa, ka, va, qb, kb, vb, qc, kc, vc = jnp.split(proj, IN_SPLITS, axis=-1)
        oa = window_attention(qa.reshape(bsz, s_len, A_HEADS, HEAD_DIM),
                              ka.reshape(bsz, s_len, A_KV_HEADS, HEAD_DIM),
                              va.reshape(bsz, s_len, A_KV_HEADS, HEAD_DIM),
                              a_sink[l], t5_table)
        ob = neighborhood_attention(qb.reshape(bsz, s_len, B_HEADS, HEAD_DIM),
                                    kb.reshape(bsz, s_len, B_HEADS, HEAD_DIM),
                                    vb.reshape(bsz, s_len, B_HEADS, HEAD_DIM),
                                    b_rpb[l])
        oc = axial_global_attention(qc.reshape(bsz, s_len, C_HEADS, HEAD_DIM),
                                    kc.reshape(bsz, s_len, C_KV_HEADS, HEAD_DIM),
                                    vc.reshape(bsz, s_len, C_KV_HEADS, HEAD_DIM),
                                    c_q_gain[l], c_k_gain[l])
        mix = jnp.concatenate([rmsnorm(oa, out_gain_a[l]),
                               rmsnorm(ob, out_gain_b[l]),
                               rmsnorm(oc, out_gain_c[l])], axis=-1)
        x = x + jnp.einsum('bse,ed->bsd', mix, w_o[l])
        h = rmsnorm(x, norm_mlp[l])
        u = jax.nn.relu(jnp.einsum('bsd,df->bsf', h, w_up[l]))
        x = x + jnp.einsum('bsf,fd->bsd', u * u, w_down[l])
    return rmsnorm(x, norm_final)
```

```cpp
#include <hip/hip_runtime.h>
#include <hip/hip_cooperative_groups.h>
#include <cstdio>
#include <cstdint>
namespace cg = cooperative_groups;
namespace pg8 {
#define PG8_LAS __attribute__((address_space(3)))
typedef unsigned short bf16_t;
typedef short bf16x8 __attribute__((ext_vector_type(8)));
typedef float f32x4 __attribute__((ext_vector_type(4)));
typedef unsigned u32x4 __attribute__((ext_vector_type(4)));
constexpr int BM = 256, BK = 64, HALF = 128, HTB = HALF * BK * 2  , STAGE_BYTES = 8 * HTB, NXCD = 8, WGM = 8;

__host__ __device__ __forceinline__ int lds_byte(int r, int c) { const int st = (r >> 4) * 2 + (c >> 5), rr = r & 15, cc = c & 31, ob = rr * 64 + cc * 2; return st * 1024 + (ob ^ (((ob >> 9) & 1) << 5)); }
__host__ __device__ __forceinline__ void stage_rc(int b, int& R, int& C) { const int st = b / 1024, sb = b % 1024, swz = sb ^ (((sb >> 9) & 1) << 5); R = (st >> 1) * 16 + swz / 64; C = (st & 1) * 32 + (swz % 64) / 2; }
__host__ __device__ __forceinline__ int perm32(int rho) { const int n = rho >> 4, i = rho & 15; return 8 * (i >> 2) + 4 * n + (i & 3); }

struct Unit { int pm, pn; };
struct Gemm { const bf16_t* A; const bf16_t* Bt; int M, N, K; };

struct StaticOrder {
    int nM, nN, nwg, G, c;
    __host__ __device__ void init(int M, int N, int G_, int c_) { nM = M / BM; nN = N / BM; nwg = nM * nN; G = G_; c = c_; }
    __host__ __device__ bool next(int i, Unit& u) const {
        const long L = (long)i * G + c; if (L >= nwg) return false;
        int wgid = (int)L; { const int q = nwg / NXCD, r = nwg % NXCD, xcd = wgid % NXCD, off = wgid / NXCD; wgid = (xcd < r ? xcd * (q + 1) : r * (q + 1) + (xcd - r) * q) + off; }
        const int nig = WGM * nN, gid = wgid / nig, fm = gid * WGM, gsz = (nM - fm) < WGM ? (nM - fm) : WGM;
        u.pm = fm + ((wgid % nig) % gsz); u.pn = (wgid % nig) / gsz; return true;
    }
    __device__ __forceinline__ void a_ready(const Unit&) const {}
    __device__ __forceinline__ void done(const Unit&) const {}
};

typedef float f32x2_t __attribute__((ext_vector_type(2))); typedef __bf16 bf16x2_t __attribute__((ext_vector_type(2)));
__device__ __forceinline__ unsigned cvt_pk_bf16(float lo, float hi) { f32x2_t v = {lo, hi}; bf16x2_t b = __builtin_convertvector(v, bf16x2_t); return __builtin_bit_cast(unsigned, b); }

template <int ACT  > struct EpiBf16 {
    static constexpr bool PERM = true, AFTER_DRAIN = false;
    bf16_t* O; int ldc; const PG8_LAS float* rstab;
    __device__ __forceinline__ void operator()(const f32x4 (&acc)[2][2][4][2], const Unit& u, int wr, int wc, int fr, int fq, int ui) const {
        const int row0 = u.pm * BM + wr * 64 + fr; const int col0 = u.pn * BM + 64 * wc + 8 * fq;
#pragma unroll
        for (int ai = 0; ai < 2; ++ai)
#pragma unroll
            for (int m = 0; m < 4; ++m) { const int row = row0 + ai * HALF + m * 16; bf16_t* rowp = O + (size_t)row * ldc + col0;
                const float rs = rstab[ui * 256 + wr * 64 + fr + ai * HALF + m * 16];
#pragma unroll
                for (int bj = 0; bj < 2; ++bj) { f32x4 v0 = acc[ai][bj][m][0] * rs, v1 = acc[ai][bj][m][1] * rs;
                    if (ACT == 2) {
#pragma unroll
                        for (int e = 0; e < 4; ++e) { const float a = fmaxf(v0[e], 0.f), b = fmaxf(v1[e], 0.f); v0[e] = a * a; v1[e] = b * b; } }
                    u32x4 w; w.x = cvt_pk_bf16(v0[0], v0[1]); w.y = cvt_pk_bf16(v0[2], v0[3]); w.z = cvt_pk_bf16(v1[0], v1[1]); w.w = cvt_pk_bf16(v1[2], v1[3]);
                    *(u32x4*)(rowp + 32 * bj) = w; } }
    }
};
struct EpiInProj {
    static constexpr bool PERM = true, AFTER_DRAIN = false;
    bf16_t* O; bf16_t* VT; const PG8_LAS float* rstab; const float* qgain; const float* kgain;
    __device__ __forceinline__ void operator()(const f32x4 (&acc)[2][2][4][2], const Unit& u, int wr, int wc, int fr, int fq, int ui) const {
        constexpr int LDC = 3840, SEQL = 8192;
        const int pn = u.pn, row0 = u.pm * BM + wr * 64 + fr, colh = pn * BM + 64 * wc;
        int mode = 0, vslot = 0;
        if (pn >= 9 && pn <= 12) mode = 1; else if (pn == 13) mode = 2; else if (pn == 14) { mode = 3; vslot = 10 + wc; }
        else if (pn == 7 || pn == 8) { mode = 3; vslot = 2 + 4 * (pn - 7) + wc; } else if (pn == 2 && wc >= 2) { mode = 3; vslot = wc - 2; }
        if (mode == 0) {
#pragma unroll
            for (int ai = 0; ai < 2; ++ai)
#pragma unroll
                for (int m = 0; m < 4; ++m) { const int row = row0 + ai * HALF + m * 16; bf16_t* rowp = O + (size_t)row * LDC + colh + 8 * fq;
                    const float rs = rstab[ui * 256 + wr * 64 + fr + ai * HALF + m * 16];
#pragma unroll
                    for (int bj = 0; bj < 2; ++bj) { const f32x4 v0 = acc[ai][bj][m][0] * rs, v1 = acc[ai][bj][m][1] * rs;
                        u32x4 w; w.x = cvt_pk_bf16(v0[0], v0[1]); w.y = cvt_pk_bf16(v0[2], v0[3]); w.z = cvt_pk_bf16(v1[0], v1[1]); w.w = cvt_pk_bf16(v1[2], v1[3]);
                        *(u32x4*)(rowp + 32 * bj) = w; }
                    __builtin_amdgcn_sched_barrier(0); }
        } else if (mode == 3) {
#pragma unroll
            for (int ai = 0; ai < 2; ++ai)
#pragma unroll
                for (int m = 0; m < 4; ++m) { const int row = row0 + ai * HALF + m * 16;
                    const float rs = rstab[ui * 256 + wr * 64 + fr + ai * HALF + m * 16];
                    bf16_t* dst = VT + ((size_t)((row >> 13) * 14 + vslot) * 64 + 8 * fq) * SEQL + (row & (SEQL - 1));
#pragma unroll
                    for (int bj = 0; bj < 2; ++bj)
#pragma unroll
                        for (int n = 0; n < 2; ++n) { const f32x4 v = acc[ai][bj][m][n] * rs; const unsigned w0 = cvt_pk_bf16(v[0], v[1]), w1 = cvt_pk_bf16(v[2], v[3]);
                            bf16_t* dp = dst + (size_t)(32 * bj + 4 * n) * SEQL;
                            dp[0] = (bf16_t)(w0 & 0xffffu); dp[SEQL] = (bf16_t)(w0 >> 16); dp[2 * SEQL] = (bf16_t)(w1 & 0xffffu); dp[3 * SEQL] = (bf16_t)(w1 >> 16); }
                    __builtin_amdgcn_sched_barrier(0); }
        } else {
            const float* gp = (mode == 1 ? qgain : kgain) + 8 * fq;
            float g[2][8];
#pragma unroll
            for (int bj = 0; bj < 2; ++bj)
#pragma unroll
                for (int e = 0; e < 8; ++e) g[bj][e] = gp[32 * bj + e];
            const float osc = (mode == 1) ? 0.125f * 1.4426950408889634f : 1.f;
            const float fsc = (fq & 1) ? 0.01f : 1.f;
            const float sgn = (fq < 2) ? -1.f : 1.f;
#pragma unroll
            for (int ai = 0; ai < 2; ++ai)
#pragma unroll
                for (int m = 0; m < 4; ++m) { const int row = row0 + ai * HALF + m * 16; bf16_t* rowp = O + (size_t)row * LDC + colh + 8 * fq;
                    const float rs = rstab[ui * 256 + wr * 64 + fr + ai * HALF + m * 16];
                    float x[2][8]; float q = 0.f;
#pragma unroll
                    for (int bj = 0; bj < 2; ++bj)
#pragma unroll
                        for (int e = 0; e < 8; ++e) { x[bj][e] = acc[ai][bj][m][e >> 2][e & 3] * rs; q += x[bj][e] * x[bj][e]; }
                    q += __shfl_xor(q, 16); q += __shfl_xor(q, 32);
                    const float rr = __builtin_amdgcn_rsqf(q * (1.f / 64.f) + 1e-6f) * osc;
                    int pos = row & (SEQL - 1); asm volatile("" : "+v"(pos));
#pragma unroll
                    for (int bj = 0; bj < 2; ++bj) { const float axv = (float)(bj ? (pos & 63) : (pos >> 6)) * fsc; float o[8];
#pragma unroll
                        for (int e = 0; e < 8; ++e) { const float y = x[bj][e] * rr * g[bj][e]; const float p = __shfl_xor(y, 32);
                            const float fr_ = (e == 0 ? 1.f : e == 1 ? 0.5623413251903491f : e == 2 ? 0.31622776601683794f : e == 3 ? 0.1778279410038923f : e == 4 ? 0.1f : e == 5 ? 0.05623413251903491f : e == 6 ? 0.031622776601683794f : 0.01778279410038923f);
                            const float ang = axv * fr_ * 0.15915494309189535f;
                            const float cs = __builtin_amdgcn_cosf(ang), sn = __builtin_amdgcn_sinf(ang);
                            o[e] = y * cs + sgn * p * sn; }
                        u32x4 w; w.x = cvt_pk_bf16(o[0], o[1]); w.y = cvt_pk_bf16(o[2], o[3]); w.z = cvt_pk_bf16(o[4], o[5]); w.w = cvt_pk_bf16(o[6], o[7]);
                        *(u32x4*)(rowp + 32 * bj) = w; }
                    __builtin_amdgcn_sched_barrier(0); }
        }
    }
};
typedef unsigned u32x2 __attribute__((ext_vector_type(2)));
struct EpiResBf16 {
    static constexpr bool PERM = true, AFTER_DRAIN = false;
    bf16_t* xb; int ldc; unsigned long long* ssq;
    __device__ __forceinline__ void operator()(const f32x4 (&acc)[2][2][4][2], const Unit& u, int wr, int wc, int fr, int fq, int ui) const {
        const int row0 = u.pm * BM + wr * 64 + fr; const int col0 = u.pn * BM + 64 * wc + 8 * fq;
#pragma unroll
        for (int ai = 0; ai < 2; ++ai) {
            u32x4 bs[4][2];
#pragma unroll
            for (int m = 0; m < 4; ++m) { const bf16_t* rowp = xb + (size_t)(row0 + ai * HALF + m * 16) * ldc + col0;
#pragma unroll
                for (int bj = 0; bj < 2; ++bj) bs[m][bj] = *(const u32x4*)(rowp + 32 * bj); }
#pragma unroll
            for (int m = 0; m < 4; ++m) { const int row = row0 + ai * HALF + m * 16; bf16_t* rowp = xb + (size_t)row * ldc + col0;
                float q = 0.f;
#pragma unroll
                for (int bj = 0; bj < 2; ++bj) { u32x4 w;
#pragma unroll
                    for (int p = 0; p < 4; ++p) { const f32x4 a = acc[ai][bj][m][p >> 1]; const unsigned b = bs[m][bj][p];
                        const float lo = __uint_as_float(b << 16) + a[2 * (p & 1)], hi = __uint_as_float(b & 0xffff0000u) + a[2 * (p & 1) + 1];
                        const unsigned pk = cvt_pk_bf16(lo, hi); w[p] = pk;
                        const float rl = __uint_as_float(pk << 16), rh = __uint_as_float(pk & 0xffff0000u); q += rl * rl + rh * rh; }
                    *(u32x4*)(rowp + 32 * bj) = w; }
                q += __shfl_xor(q, 16); q += __shfl_xor(q, 32);
                if (fq == 0) atomicAdd(ssq + row, (unsigned long long)(q * 16777216.f)); }
            asm volatile("" ::: "memory");
        }
    }
};

struct NoHook { static constexpr bool ENABLED = false; __device__ __forceinline__ void operator()(f32x4 (&)[2][2][4][2], int, int, int, int, int) const {} };
struct MixHook { static constexpr bool ENABLED = true; const PG8_LAS float* tab;
    __device__ __forceinline__ void operator()(f32x4 (&acc)[2][2][4][2], int t, int nt, int ui, int wr, int fr) const {
        int sel; if (t == 8) sel = 0; else if (t == 16) sel = 1; else if (t == nt) sel = 2; else return;
        const PG8_LAS float* f = tab + (ui * 3 + sel) * 256 + wr * 64 + fr;
#pragma unroll
        for (int ai = 0; ai < 2; ++ai)
#pragma unroll
            for (int m = 0; m < 4; ++m) { const float sc = f[ai * HALF + m * 16];
#pragma unroll
                for (int bj = 0; bj < 2; ++bj)
#pragma unroll
                    for (int n = 0; n < 2; ++n) acc[ai][bj][m][n] = acc[ai][bj][m][n] * sc; }
    }
};
template <class Epi, class Sched, bool ALIGN_EPI = false, bool SP2 = false, class Hook = NoHook, bool REVK = false>
__device__ __forceinline__ void gemm_phase(PG8_LAS unsigned char* lds, const Gemm g, const Sched& S, const Epi& E, const Hook H = Hook()) {
    int tid_ = threadIdx.x; asm volatile("" : "+v"(tid_));
    const int tid = tid_, wid = __builtin_amdgcn_readfirstlane(tid >> 6), lane = tid & 63, wr = wid >> 2, wc = wid & 3, fr = lane & 15, fq = lane >> 4;
    const int K = g.K, nt = K / BK;
    unsigned voffA[2], voffB[2];
#pragma unroll
    for (int i = 0; i < 2; ++i) { int R, C; stage_rc(tid * 16 + i * 8192, R, C); const int Rb = Epi::PERM ? ((R & ~31) + perm32(R & 31)) : R;
        voffA[i] = (unsigned)(R * K + C) * 2u; voffB[i] = (unsigned)(Rb * K + C) * 2u; }
    const long kstep = REVK ? -(long)(BK * 2) : (long)(BK * 2);
    const size_t krev = REVK ? (size_t)(K / BK - 1) * (size_t)(BK * 2) : 0;
    const size_t hstep = (size_t)HALF * K * 2;
    const size_t tstep = 2 * hstep;
    const unsigned ldsw = (unsigned)wid * 1024u;
    const int aoff = lds_byte(wr * 64 + fr, fq * 8), boff = lds_byte(wc * 32 + fr, fq * 8);
#define PG8_SA(b, h) (((b) * 2 + (h)) * HTB)
#define PG8_SB(b, h) ((4 + (b) * 2 + (h)) * HTB)
#define PG8_STAGE(bufoff, gbase, voff) do { _Pragma("unroll") for (int _i = 0; _i < 2; ++_i) \
        __builtin_amdgcn_global_load_lds((const unsigned*)((const char*)(gbase) + (voff)[_i]), (PG8_LAS unsigned*)(lds + (bufoff) + ldsw + _i * 8192), 16, 0, 0); } while (0)
#define PG8_LDA(dst, b, h) do { _Pragma("unroll") for (int m = 0; m < 4; ++m) _Pragma("unroll") for (int k = 0; k < 2; ++k) dst[m][k] = *(const PG8_LAS bf16x8*)(lds + PG8_SA(b, h) + aoff + m * 2048 + k * 1024); } while (0)
#define PG8_LDB(dst, b, h) do { _Pragma("unroll") for (int n = 0; n < 2; ++n) _Pragma("unroll") for (int k = 0; k < 2; ++k) dst[n][k] = *(const PG8_LAS bf16x8*)(lds + PG8_SB(b, h) + boff + n * 2048 + k * 1024); } while (0)
#define PG8_MMA(ai, bj, At, Bt) do { __builtin_amdgcn_s_setprio(1); _Pragma("unroll") for (int m = 0; m < 4; ++m) _Pragma("unroll") for (int n = 0; n < 2; ++n) _Pragma("unroll") for (int k = 0; k < 2; ++k) \
        acc[ai][bj][m][n] = __builtin_amdgcn_mfma_f32_16x16x32_bf16(Bt[n][k], At[m][k], acc[ai][bj][m][n], 0, 0, 0); __builtin_amdgcn_s_setprio(0); } while (0)
#define PG8_WAIT_V(n) asm volatile("s_waitcnt vmcnt(" #n ")" ::: "memory")
#define PG8_WAIT_L(n) asm volatile("s_waitcnt lgkmcnt(" #n ")" ::: "memory")
#define PG8_BAR __builtin_amdgcn_s_barrier()
#define PG8_SCHED __builtin_amdgcn_sched_barrier(0)
    Unit cur, nxt; int ui = 0;
    if (!S.next(0, cur)) return;
    f32x4 acc[2][2][4][2];
#pragma unroll
    for (int a = 0; a < 2; ++a)
#pragma unroll
        for (int b = 0; b < 2; ++b)
#pragma unroll
            for (int m = 0; m < 4; ++m)
#pragma unroll
                for (int n = 0; n < 2; ++n) acc[a][b][m][n] = (f32x4){0.f, 0.f, 0.f, 0.f};
    bf16x8 At[4][2], B0[2][2], B1[2][2];
    const char* cA = (const char*)g.A + (size_t)cur.pm * tstep + krev; const char* cB = (const char*)g.Bt + (size_t)cur.pn * tstep + krev;
    S.a_ready(cur);
    if constexpr (SP2) {
        PG8_STAGE(PG8_SB(0, 0), cB, voffB); PG8_STAGE(PG8_SB(0, 1), cB + hstep, voffB); PG8_STAGE(PG8_SA(0, 0), cA, voffA); PG8_STAGE(PG8_SA(0, 1), cA + hstep, voffA);
        if (wr == 1) PG8_BAR;
        PG8_WAIT_V(2); PG8_BAR;
        PG8_STAGE(PG8_SB(1, 0), cB + kstep, voffB); PG8_STAGE(PG8_SA(1, 0), cA + kstep, voffA); PG8_STAGE(PG8_SB(1, 1), cB + hstep + kstep, voffB);
        PG8_WAIT_V(6); PG8_BAR;
    } else {
        PG8_STAGE(PG8_SB(0, 0), cB, voffB); PG8_STAGE(PG8_SA(0, 0), cA, voffA); PG8_STAGE(PG8_SB(0, 1), cB + hstep, voffB); PG8_STAGE(PG8_SA(0, 1), cA + hstep, voffA);
        if (wr == 1) PG8_BAR;
        PG8_WAIT_V(4); PG8_BAR;
        PG8_STAGE(PG8_SB(1, 0), cB + kstep, voffB); PG8_STAGE(PG8_SA(1, 0), cA + kstep, voffA); PG8_STAGE(PG8_SB(1, 1), cB + hstep + kstep, voffB);
        PG8_WAIT_V(6); PG8_BAR;
    }
    for (;;) {
        const bool has_next = S.next(ui + 1, nxt);
        const char* nA = has_next ? (const char*)g.A + (size_t)nxt.pm * tstep + krev : cA; const char* nB = has_next ? (const char*)g.Bt + (size_t)nxt.pn * tstep + krev : cB;
        for (int t = 0; t < nt; t += 2) {
            if constexpr (Hook::ENABLED) H(acc, t, nt, ui, wr, fr);
            const bool last = (t == nt - 2);
            const char* a1 = cA + (long)(t + 1) * kstep;
            const char* a2 = last ? nA : cA + (long)(t + 2) * kstep; const char* b2 = last ? nB : cB + (long)(t + 2) * kstep;
            const char* a3 = a2 + kstep; const char* b3 = b2 + kstep;
            if (last && has_next) S.a_ready(nxt);
            if constexpr (SP2) {
            PG8_LDB(B0, 0, 0); PG8_LDB(B1, 0, 1); PG8_SCHED; PG8_LDA(At, 0, 0); PG8_STAGE(PG8_SA(1, 1), a1 + hstep, voffA);
            PG8_WAIT_V(8); PG8_WAIT_L(0); PG8_BAR; PG8_MMA(0, 0, At, B0); PG8_MMA(0, 1, At, B1); PG8_BAR; PG8_SCHED;
            PG8_LDA(At, 0, 1); PG8_STAGE(PG8_SB(0, 0), b2, voffB); PG8_STAGE(PG8_SB(0, 1), b2 + hstep, voffB); PG8_STAGE(PG8_SA(0, 0), a2, voffA);
            PG8_WAIT_V(8); PG8_WAIT_L(0); PG8_BAR; PG8_MMA(1, 0, At, B0); PG8_MMA(1, 1, At, B1); PG8_BAR; PG8_SCHED;
            PG8_LDB(B0, 1, 0); PG8_LDB(B1, 1, 1); PG8_SCHED; PG8_LDA(At, 1, 0); PG8_STAGE(PG8_SA(0, 1), a2 + hstep, voffA);
            PG8_WAIT_V(8); PG8_WAIT_L(0); PG8_BAR; PG8_MMA(0, 0, At, B0); PG8_MMA(0, 1, At, B1); PG8_BAR; PG8_SCHED;
            PG8_LDA(At, 1, 1); PG8_STAGE(PG8_SB(1, 0), b3, voffB); PG8_STAGE(PG8_SB(1, 1), b3 + hstep, voffB); PG8_STAGE(PG8_SA(1, 0), a3, voffA);
            PG8_WAIT_V(8); PG8_WAIT_L(0); PG8_BAR; PG8_MMA(1, 0, At, B0); PG8_MMA(1, 1, At, B1); PG8_BAR; PG8_SCHED;
            } else {
            PG8_LDB(B0, 0, 0); PG8_SCHED; PG8_LDA(At, 0, 0); PG8_STAGE(PG8_SA(1, 1), a1 + hstep, voffA);
            PG8_WAIT_L(8); PG8_BAR; PG8_WAIT_L(0); PG8_MMA(0, 0, At, B0); PG8_BAR; PG8_SCHED;
            PG8_LDB(B1, 0, 1); PG8_STAGE(PG8_SB(0, 0), b2, voffB);
            PG8_BAR; PG8_WAIT_L(0); PG8_MMA(0, 1, At, B1); PG8_BAR;
            PG8_LDA(At, 0, 1); PG8_STAGE(PG8_SA(0, 0), a2, voffA);
            PG8_BAR; PG8_WAIT_L(0); PG8_MMA(1, 0, At, B0); PG8_BAR; PG8_SCHED;
            PG8_STAGE(PG8_SB(0, 1), b2 + hstep, voffB);
            PG8_WAIT_V(6); PG8_BAR; PG8_MMA(1, 1, At, B1); PG8_BAR;
            PG8_LDB(B0, 1, 0); PG8_SCHED; PG8_LDA(At, 1, 0); PG8_STAGE(PG8_SA(0, 1), a2 + hstep, voffA);
            PG8_WAIT_L(8); PG8_BAR; PG8_WAIT_L(0); PG8_MMA(0, 0, At, B0); PG8_BAR; PG8_SCHED;
            PG8_LDB(B1, 1, 1); PG8_STAGE(PG8_SB(1, 0), b3, voffB);
            PG8_BAR; PG8_WAIT_L(0); PG8_MMA(0, 1, At, B1); PG8_BAR;
            PG8_LDA(At, 1, 1); PG8_STAGE(PG8_SA(1, 0), a3, voffA);
            PG8_BAR; PG8_WAIT_L(0); PG8_MMA(1, 0, At, B0); PG8_BAR; PG8_SCHED;
            PG8_STAGE(PG8_SB(1, 1), b3 + hstep, voffB);
            PG8_WAIT_V(6); PG8_BAR; PG8_MMA(1, 1, At, B1); PG8_BAR;
            }
        }
        if constexpr (Hook::ENABLED) H(acc, nt, nt, ui, wr, fr);
        if constexpr (ALIGN_EPI) { if (wr == 0) PG8_BAR; }
        if constexpr (!Epi::AFTER_DRAIN) { E(acc, cur, wr, wc, fr, fq, ui); S.done(cur); }
        if (!has_next) break;
#pragma unroll
        for (int a = 0; a < 2; ++a)
#pragma unroll
            for (int b = 0; b < 2; ++b)
#pragma unroll
                for (int m = 0; m < 4; ++m)
#pragma unroll
                    for (int n = 0; n < 2; ++n) acc[a][b][m][n] = (f32x4){0.f, 0.f, 0.f, 0.f};
        cur = nxt; cA = nA; cB = nB; ++ui;
        if constexpr (ALIGN_EPI) { if (wr == 1) PG8_BAR; }
    }
    PG8_WAIT_V(0);
    if constexpr (!ALIGN_EPI) { if (wr == 0) PG8_BAR; }
    PG8_BAR;
    if constexpr (Epi::AFTER_DRAIN) { E.fused(acc, cur, wr, wc, fr, fq, lds, wid, lane); S.done(cur); }
#undef PG8_SA
#undef PG8_SB
#undef PG8_STAGE
#undef PG8_LDA
#undef PG8_LDB
#undef PG8_MMA
#undef PG8_WAIT_V
#undef PG8_WAIT_L
#undef PG8_BAR
#undef PG8_SCHED
}
}

typedef unsigned short bf16_t;
#define LAS __attribute__((address_space(3)))
typedef short bf16x8 __attribute__((ext_vector_type(8)));
typedef float f32x4 __attribute__((ext_vector_type(4)));
typedef float f32x16 __attribute__((ext_vector_type(16)));
typedef unsigned u32x4 __attribute__((ext_vector_type(4)));
typedef unsigned u32x2 __attribute__((ext_vector_type(2)));

constexpr int BATCH = 2, SEQ = 8192, DM = 2048, DEPTH = 4, MTOK = BATCH * SEQ, INW = 3840, DFF = 8192;
constexpr int QA_OFF = 0, KA_OFF = 512, VA_OFF = 640, QB_OFF = 768, KB_OFF = 1280, VB_OFF = 1792, QC_OFF = 2304, KC_OFF = 3328, VC_OFF = 3584;
constexpr int NVS = 14;
constexpr float LOG2E = 1.4426950408889634f;
constexpr float C2 = 0.125f * 1.4426950408889634f;
constexpr float EPS = 1e-6f;
constexpr float NEGBIG = -1e30f;

constexpr size_t SZ_WIN = (size_t)INW * DM * 2, SZ_WO = (size_t)DM * DM * 2, SZ_WUP = (size_t)DFF * DM * 2, SZ_WDN = (size_t)DM * DFF * 2;
constexpr size_t WS_WIN = 0;
constexpr size_t WS_WO = WS_WIN + DEPTH * SZ_WIN;
constexpr size_t WS_WUP = WS_WO + DEPTH * SZ_WO;
constexpr size_t WS_WDN = WS_WUP + DEPTH * SZ_WUP;
constexpr size_t WS_H = WS_WDN + DEPTH * SZ_WDN;
constexpr size_t WS_PROJ = WS_H + (size_t)MTOK * DM * 2;
constexpr size_t WS_VT = WS_PROJ + (size_t)MTOK * INW * 2;
constexpr size_t WS_O = WS_VT + (size_t)BATCH * NVS * 64 * SEQ * 2;
constexpr size_t WS_MIX = WS_O + (size_t)MTOK * DM * 2;
constexpr size_t WS_MIXEND = WS_MIX + (size_t)MTOK * DM * 2;
constexpr size_t WS_SS = WS_MIXEND;
constexpr size_t WS_SG = WS_SS + (size_t)(2 * DEPTH + 1) * MTOK * 8;
constexpr size_t WS_BAR = WS_SG + (size_t)DEPTH * 3 * MTOK * 8;
constexpr size_t WS_END = WS_BAR + 16384;
constexpr size_t WS_U = WS_PROJ;
static_assert(WS_U + (size_t)MTOK * DFF * 2 <= WS_MIXEND, "U overlay");
constexpr int LDS_BYTES = 147456;

struct Params {
    const float *x, *norm_mix, *w_in, *a_sink, *t5, *b_rpb, *c_q_gain, *c_k_gain, *og_a, *og_b, *og_c, *w_o, *norm_mlp, *w_up, *w_down, *norm_final;
    float* out; unsigned char* ws;
};
typedef const __attribute__((address_space(4))) Params* CP;
#define PP() ({ CP q_ = (CP)__builtin_amdgcn_kernarg_segment_ptr(); asm volatile("" : "+s"(q_)); q_; })

__device__ __forceinline__ float wave_sum(float v) {
#pragma unroll
    for (int o = 1; o < 64; o <<= 1) v += __shfl_xor(v, o);
    return v;
}
__device__ __forceinline__ unsigned pk_bf16(float lo, float hi) { return pg8::cvt_pk_bf16(lo, hi); }
__device__ __forceinline__ float bf_lo(unsigned w) { return __uint_as_float(w << 16); }
__device__ __forceinline__ float bf_hi(unsigned w) { return __uint_as_float(w & 0xffff0000u); }

constexpr int WI_IN = (DM / 64) * (INW / 32), WI_O = (DM / 64) * (DM / 32), WI_UP = (DM / 64) * (DFF / 32), WI_DN = (DFF / 64) * (DM / 32);
constexpr int W_PER_L = WI_IN + WI_O + WI_UP + WI_DN;
constexpr int W_DEFER = 6144;
struct WItem { const float* src; bf16_t* dst; const float* kg; int N, K; };
__device__ __forceinline__ void witem_desc(CP P, int l, int r, int lane, WItem& d) {
    unsigned char* ws = P->ws;
    const float* W; bf16_t* WT; const float* kgain; int K, N; const bool permute = true;
    if (r < WI_IN) { W = P->w_in + (size_t)l * DM * INW; K = DM; N = INW; WT = (bf16_t*)(ws + WS_WIN + l * SZ_WIN); kgain = P->norm_mix + l * DM; }
    else if ((r -= WI_IN) < WI_O) { W = P->w_o + (size_t)l * DM * DM; K = DM; N = DM; WT = (bf16_t*)(ws + WS_WO + l * SZ_WO);
        const int kk = 64 * (r / (DM / 32));
        kgain = kk < 512 ? P->og_a + l * 512 : kk < 1024 ? P->og_b + l * 512 - 512 : P->og_c + l * 1024 - 1024; }
    else if ((r -= WI_O) < WI_UP) { W = P->w_up + (size_t)l * DM * DFF; K = DM; N = DFF; WT = (bf16_t*)(ws + WS_WUP + l * SZ_WUP); kgain = P->norm_mlp + l * DM; }
    else { r -= WI_UP; W = P->w_down + (size_t)l * DFF * DM; K = DFF; N = DM; WT = (bf16_t*)(ws + WS_WDN + l * SZ_WDN); kgain = nullptr; }
    const int nblk = N / 32, kb = r / nblk, nb = r % nblk, k0 = 64 * kb, n0 = 32 * nb;
    const int d0 = permute ? (n0 & ~255) + 32 * (4 * (nb & 1) + ((nb & 7) >> 1)) : n0;
    const int g = lane & 7, nq = lane >> 3;
    d.src = W + (size_t)(k0 + 8 * g) * N + n0 + 4 * nq; d.dst = WT + (size_t)(d0 + 4 * nq) * K + k0 + 8 * g; d.kg = kgain ? kgain + k0 + 8 * g : nullptr; d.N = N; d.K = K;
}
__device__ __forceinline__ void witem_load(const WItem& d, f32x4 (&v)[8]) {
#pragma unroll
    for (int t = 0; t < 8; ++t) v[t] = __builtin_nontemporal_load((const f32x4*)(d.src + (size_t)t * d.N));
}
__device__ __forceinline__ void witem_finish(const WItem& d, f32x4 (&v)[8]) {
    if (d.kg) { const f32x4 g0 = *(const f32x4*)(d.kg), g1 = *(const f32x4*)(d.kg + 4);
#pragma unroll
        for (int t = 0; t < 4; ++t) { v[t] = v[t] * g0[t]; v[4 + t] = v[4 + t] * g1[t]; } }
#pragma unroll
    for (int j = 0; j < 4; ++j) { u32x4 o; o.x = pk_bf16(v[0][j], v[1][j]); o.y = pk_bf16(v[2][j], v[3][j]); o.z = pk_bf16(v[4][j], v[5][j]); o.w = pk_bf16(v[6][j], v[7][j]);
        __builtin_nontemporal_store(o, (u32x4*)(d.dst + (size_t)j * d.K)); }
}
template <class IDX>
__device__ __forceinline__ void weights_run(CP P, int total, int widx, int nw, int lane, const IDX& idx) {
    for (int it = widx; it < total; it += 2 * nw) {
        const bool two = it + nw < total;
        int la, ra, lb, rb; idx(it, la, ra); idx(two ? it + nw : it, lb, rb);
        WItem A, B; witem_desc(P, la, ra, lane, A); witem_desc(P, lb, rb, lane, B);
        f32x4 va[8], vb[8];
        witem_load(A, va); if (two) witem_load(B, vb);
        witem_finish(A, va); if (two) witem_finish(B, vb);
    }
}
__device__ __forceinline__ void weights_phase(CP P, LAS unsigned char* lds) {
    int tid_ = threadIdx.x; asm volatile("" : "+v"(tid_));
    const int lane = tid_ & 63, wave = __builtin_amdgcn_readfirstlane(tid_ >> 6);
    constexpr int REST = W_PER_L - W_DEFER;
    weights_run(P, DEPTH * REST, blockIdx.x * 8 + wave, gridDim.x * 8, lane,
                [](int i, int& l, int& r) { l = i / REST; const int j = i % REST; r = j < WI_IN ? j : j + W_DEFER; });
}
__device__ __forceinline__ void weights_deferred(CP P, int layer) {
    const int G = gridDim.x, c = blockIdx.x, rem = ((MTOK / 256) * (INW / 256)) % G;
    if (rem != 0 && c < rem) return;
    int tid_ = threadIdx.x; asm volatile("" : "+v"(tid_));
    const int lane = tid_ & 63, wave = __builtin_amdgcn_readfirstlane(tid_ >> 6);
    const int rank = rem ? c - rem : c, cnt = rem ? G - rem : G;
    weights_run(P, W_DEFER, rank * 8 + wave, cnt * 8, lane, [layer](int i, int& l, int& r) { l = layer; r = WI_IN + i; });
}

__device__ __forceinline__ void xinit_phase(const float* xin, bf16_t* xb, unsigned long long* ss) {
    int tid_ = threadIdx.x; asm volatile("" : "+v"(tid_));
    const int lane = tid_ & 63, wave = __builtin_amdgcn_readfirstlane(tid_ >> 6);
    const int gw = blockIdx.x * 8 + wave, NGW = gridDim.x * 8;
    for (int i = blockIdx.x * 512 + tid_; i < (2 * DEPTH + 3 * DEPTH) * MTOK; i += gridDim.x * 512) ss[MTOK + i] = 0ull;
    for (int row = gw; row < MTOK; row += NGW) {
        const f32x4* xr = (const f32x4*)(xin + (size_t)row * DM) + lane;
        u32x2* o = (u32x2*)(xb + (size_t)row * DM) + lane;
        float s = 0.f;
#pragma unroll
        for (int j = 0; j < 8; ++j) { const f32x4 v = xr[64 * j]; u32x2 w; w.x = pk_bf16(v.x, v.y); w.y = pk_bf16(v.z, v.w); o[64 * j] = w;
            const float a = bf_lo(w.x), b = bf_hi(w.x), c = bf_lo(w.y), d = bf_hi(w.y); s += (a * a + b * b) + (c * c + d * d); }
        s = wave_sum(s);
        if (lane == 0) ss[row] = (unsigned long long)(s * 16777216.f);
    }
}
__device__ __forceinline__ void final_phase(const bf16_t* xb, float* out, const float* gain, const unsigned long long* ss) {
    int tid_ = threadIdx.x; asm volatile("" : "+v"(tid_));
    const int lane = tid_ & 63, wave = __builtin_amdgcn_readfirstlane(tid_ >> 6);
    const int gw = blockIdx.x * 8 + wave, NGW = gridDim.x * 8;
    for (int row = gw; row < MTOK; row += NGW) {
        const u32x2* xr = (const u32x2*)(xb + (size_t)row * DM) + lane;
        f32x4* o = (f32x4*)(out + (size_t)row * DM) + lane;
        const float r = rsqrtf((float)ss[row] * (1.f / (DM * 16777216.f)) + EPS);
#pragma unroll
        for (int j = 0; j < 8; ++j) { const u32x2 w = xr[64 * j]; const f32x4 g = ((const f32x4*)gain)[lane + 64 * j];
            f32x4 v; v.x = bf_lo(w.x) * r * g.x; v.y = bf_hi(w.x) * r * g.y; v.z = bf_lo(w.y) * r * g.z; v.w = bf_hi(w.y) * r * g.w; o[64 * j] = v; }
    }
}

__device__ __forceinline__ constexpr float rope_freq(int i) {
    return i == 0 ? 1.f : i == 1 ? 0.5623413251903491f : i == 2 ? 0.31622776601683794f : i == 3 ? 0.1778279410038923f :
           i == 4 ? 0.1f : i == 5 ? 0.05623413251903491f : i == 6 ? 0.031622776601683794f : i == 7 ? 0.01778279410038923f :
           i == 8 ? 0.01f : i == 9 ? 0.005623413251903491f : i == 10 ? 0.0031622776601683794f : i == 11 ? 0.001778279410038923f :
           i == 12 ? 0.001f : i == 13 ? 0.0005623413251903491f : i == 14 ? 0.00031622776601683794f : 0.0001778279410038923f;
}
__device__ __forceinline__ void prep_phase(CP P, int layer) {
    int tid_ = threadIdx.x; asm volatile("" : "+v"(tid_));
    const int lane = tid_ & 63, wave = __builtin_amdgcn_readfirstlane(tid_ >> 6);
    const int gw = blockIdx.x * 8 + wave, NGW = gridDim.x * 8;
    bf16_t* proj = (bf16_t*)(P->ws + WS_PROJ); bf16_t* vt = (bf16_t*)(P->ws + WS_VT);
    for (int it = gw; it < 34 * (MTOK / 64); it += NGW) {
        const int slot = it % 34, tb = it / 34;
        const int tok = tb * 64 + lane, pos = tok & (SEQ - 1), b = tok >> 13;
        int col;
        if (slot < 16) col = QC_OFF + 64 * slot; else if (slot < 20) col = KC_OFF + 64 * (slot - 16);
        else if (slot < 22) col = VA_OFF + 64 * (slot - 20); else if (slot < 30) col = VB_OFF + 64 * (slot - 22); else col = VC_OFF + 64 * (slot - 30);
        u32x4* p = (u32x4*)(proj + (size_t)tok * INW + col);
        u32x4 raw[8];
#pragma unroll
        for (int j = 0; j < 8; ++j) raw[j] = p[j];
        if (slot < 20) {
            const float* gn = (slot < 16 ? P->c_q_gain : P->c_k_gain) + layer * 64;
            asm volatile("" : "+s"(gn));
            float ss = 0.f;
#pragma unroll
            for (int j = 0; j < 8; ++j)
#pragma unroll
                for (int q = 0; q < 4; ++q) { const float a = bf_lo(raw[j][q]), c = bf_hi(raw[j][q]); ss += a * a + c * c; }
            const float rr = rsqrtf(ss * (1.f / 64.f) + EPS) * ((slot < 16) ? C2 : 1.f);
            const float rowf = (float)(pos >> 6), colf = (float)(pos & 63);
            u32x4 outw[8];
#pragma unroll
            for (int i = 0; i < 16; i += 2) {
                const unsigned wa = raw[i >> 3][(i & 7) >> 1], wb = raw[(16 + i) >> 3][(i & 7) >> 1], wc = raw[(32 + i) >> 3][(i & 7) >> 1], wd = raw[(48 + i) >> 3][(i & 7) >> 1];
                float r1[2], r2[2], r3[2], r4[2];
#pragma unroll
                for (int e = 0; e < 2; ++e) {
                    const int d = i + e; const float f = rope_freq(d);
                    const float x1 = (e ? bf_hi(wa) : bf_lo(wa)) * rr * gn[d], x2 = (e ? bf_hi(wb) : bf_lo(wb)) * rr * gn[16 + d];
                    const float y1 = (e ? bf_hi(wc) : bf_lo(wc)) * rr * gn[32 + d], y2 = (e ? bf_hi(wd) : bf_lo(wd)) * rr * gn[48 + d];
                    const float ar = rowf * f, ac = colf * f;
                    const float cr = __cosf(ar), sr = __sinf(ar), cc = __cosf(ac), sc = __sinf(ac);
                    r1[e] = x1 * cr - x2 * sr; r2[e] = x2 * cr + x1 * sr; r3[e] = y1 * cc - y2 * sc; r4[e] = y2 * cc + y1 * sc;
                }
                outw[i >> 3][(i & 7) >> 1] = pk_bf16(r1[0], r1[1]); outw[(16 + i) >> 3][(i & 7) >> 1] = pk_bf16(r2[0], r2[1]);
                outw[(32 + i) >> 3][(i & 7) >> 1] = pk_bf16(r3[0], r3[1]); outw[(48 + i) >> 3][(i & 7) >> 1] = pk_bf16(r4[0], r4[1]);
                __builtin_amdgcn_sched_barrier(0);
            }
#pragma unroll
            for (int j = 0; j < 8; ++j) p[j] = outw[j];
        } else {
            const int vs = slot - 20;
            bf16_t* dst = vt + ((size_t)(b * NVS + vs) * 64) * SEQ + pos;
#pragma unroll
            for (int j = 0; j < 8; ++j)
#pragma unroll
                for (int q = 0; q < 4; ++q) { const unsigned w = raw[j][q]; dst[(size_t)(8 * j + 2 * q) * SEQ] = (bf16_t)(w & 0xffffu); dst[(size_t)(8 * j + 2 * q + 1) * SEQ] = (bf16_t)(w >> 16); }
        }
    }
}

constexpr int KP = 144;
constexpr int ATT_TILE = 64 * KP;
constexpr int ATT_K = 0, ATT_V = 2 * ATT_TILE, ATT_BIAS = 4 * ATT_TILE;
__device__ __forceinline__ float sq2(unsigned w) { const float a = bf_lo(w), b = bf_hi(w); return a * a + b * b; }
__device__ __forceinline__ int t5_bucket(int rel) {
    const int base = rel > 0 ? 16 : 0; const int n = rel < 0 ? -rel : rel; int v;
    if (n < 8) v = n; else if (n < 12) v = 8; else if (n < 16) v = 9; else if (n < 23) v = 10; else if (n < 32) v = 11;
    else if (n < 46) v = 12; else if (n < 64) v = 13; else if (n < 91) v = 14; else v = 15;
    return base + v;
}
__device__ __forceinline__ int clampi(int v, int lo, int hi) { return v < lo ? lo : (v > hi ? hi : v); }

template <int MODE>
__device__ __forceinline__ void attn_unit(LAS unsigned char* lds, const bf16_t* proj, const bf16_t* vt, bf16_t* obuf,
                                          int b, int hk, int blk, const float* btab, const float* sink, unsigned long long* sg, bool build_lut) {
    int tid_ = threadIdx.x; asm volatile("" : "+v"(tid_));
    const int tid = tid_, lane = tid & 63, r = lane & 31, h = lane >> 5;
    const int w = __builtin_amdgcn_readfirstlane(tid >> 6);
    int qhead, qpos, qcol, kcol, vslot, ocol, T0, T1, w0 = 0, w1 = 0, grow = 0;
    if (MODE == 0)      { qhead = 4 * hk + (w >> 1); qpos = blk * 64 + 32 * (w & 1) + r; qcol = QA_OFF + 64 * qhead; kcol = KA_OFF + 64 * hk; vslot = hk; ocol = 64 * qhead;
                          T0 = blk - 2 < 0 ? 0 : blk - 2; T1 = blk + 2 > 127 ? 127 : blk + 2; }
    else if (MODE == 2) { qhead = 4 * hk + (w >> 1); qpos = blk * 64 + 32 * (w & 1) + r; qcol = QC_OFF + 64 * qhead; kcol = KC_OFF + 64 * hk; vslot = 10 + hk; ocol = 1024 + 64 * qhead;
                          T0 = 0; T1 = 127; }
    else                { qhead = hk; qpos = blk * 256 + 32 * w + r; qcol = QB_OFF + 64 * hk; kcol = KB_OFF + 64 * hk; vslot = 2 + hk; ocol = 512 + 64 * hk;
                          grow = 4 * blk + (w >> 1); T0 = clampi(4 * blk - 4, 0, 120); T1 = clampi(4 * blk - 1, 0, 120) + 7; w0 = clampi(grow - 4, 0, 120); w1 = w0 + 7; }
    LAS float* bias = (LAS float*)(lds + ATT_BIAS);
    float pen0[16], pen1[16];
    if (MODE == 0 && build_lut) {
        for (int idx = tid; idx < 4 * 384; idx += 512) { const int hh = idx / 384, rel = idx % 384 - 192;
            bias[idx] = (rel >= -128 && rel <= 128) ? btab[t5_bucket(rel) * 8 + 4 * hk + hh] * LOG2E : NEGBIG; }
    } else if (MODE == 1) {
        for (int idx = tid; idx < 15 * 128; idx += 512) { const int dr = idx >> 7, y = idx & 127; bias[idx] = btab[(hk * 15 + dr) * 31 + clampi(y - 48, 0, 30)] * LOG2E; }
        const int c = 32 * (w & 1) + r, cs = clampi(c - 8, 0, 48);
#pragma unroll
        for (int i = 0; i < 16; ++i) { const int k0 = 16 * (i >> 3) + 8 * h + (i & 7), k1 = k0 + 32;
            pen0[i] = (k0 >= cs && k0 < cs + 16) ? 0.f : NEGBIG; pen1[i] = (k1 >= cs && k1 < cs + 16) ? 0.f : NEGBIG; }
    }
    const size_t tokbase = (size_t)b * SEQ;
    const int srow = tid >> 3, sch = tid & 7;
    const bf16_t* kg = proj + (tokbase + srow) * INW + kcol + sch * 8;
    const bf16_t* vg = vt + ((size_t)(b * NVS + vslot) * 64 + srow) * SEQ + sch * 8;
    const unsigned sdst = srow * KP + sch * 16;
    u32x4 kreg, vreg;
    const bf16_t* qg = proj + (tokbase + qpos) * INW + qcol + 8 * h;
    bf16x8 qf[4];
#pragma unroll
    for (int ks = 0; ks < 4; ++ks) qf[ks] = *(const bf16x8*)(qg + 16 * ks);
    float m = (MODE == 0) ? sink[qhead] * LOG2E : NEGBIG;
    float l = (MODE == 0 && h == 0) ? 1.f : 0.f;
    f32x16 o0, o1;
#pragma unroll
    for (int i = 0; i < 16; ++i) { o0[i] = 0.f; o1[i] = 0.f; }
    const int pr = (r & ~12) | ((r & 4) << 1) | ((r & 8) >> 1);
    const int nT = T1 - T0 + 1;
    kreg = *(const u32x4*)(kg + (size_t)(T0 * 64) * INW); vreg = *(const u32x4*)(vg + T0 * 64);
    *(LAS u32x4*)(lds + ATT_K + sdst) = kreg; *(LAS u32x4*)(lds + ATT_V + sdst) = vreg;
    __syncthreads();
    for (int it = 0; it < nT; ++it) {
        const int T = T0 + it, buf = it & 1;
        if (it + 1 < nT) { kreg = *(const u32x4*)(kg + (size_t)((T + 1) * 64) * INW); vreg = *(const u32x4*)(vg + (T + 1) * 64); }
        const bool active = (MODE != 1) || (T >= w0 && T <= w1);
        if (active) {
            const LAS unsigned char* kb = lds + ATT_K + buf * ATT_TILE + pr * KP + 16 * h;
            f32x16 s0, s1;
#pragma unroll
            for (int i = 0; i < 16; ++i) { s0[i] = 0.f; s1[i] = 0.f; }
#pragma unroll
            for (int ks = 0; ks < 4; ++ks) {
                const bf16x8 a0 = *(const LAS bf16x8*)(kb + 32 * ks);
                const bf16x8 a1 = *(const LAS bf16x8*)(kb + 32 * KP + 32 * ks);
                s0 = __builtin_amdgcn_mfma_f32_32x32x16_bf16(a0, qf[ks], s0, 0, 0, 0);
                s1 = __builtin_amdgcn_mfma_f32_32x32x16_bf16(a1, qf[ks], s1, 0, 0, 0);
            }
            if (MODE == 0) {
                const LAS float* bh = bias + (w >> 1) * 384 + (T * 64 - qpos + 192 + 8 * h);
#pragma unroll
                for (int i = 0; i < 16; ++i) { const int o_ = 16 * (i >> 3) + (i & 7);
                    s0[i] = s0[i] * C2 + bh[o_]; s1[i] = s1[i] * C2 + bh[o_ + 32]; }
            } else if (MODE == 1) {
                const LAS float* bh = bias + (T - grow + 7) * 128 + (63 - (32 * (w & 1) + r) + 8 * h);
#pragma unroll
                for (int i = 0; i < 16; ++i) { const int o_ = 16 * (i >> 3) + (i & 7);
                    s0[i] = (s0[i] * C2 + bh[o_]) + pen0[i]; s1[i] = (s1[i] * C2 + bh[o_ + 32]) + pen1[i]; }
            }
            float mx = fmaxf(s0[0], s1[0]);
#pragma unroll
            for (int i = 1; i < 16; ++i) mx = fmaxf(mx, fmaxf(s0[i], s1[i]));
            mx = fmaxf(mx, __shfl_xor(mx, 32));
            const float mnew = fmaxf(m, mx);
            const float alpha = __builtin_amdgcn_exp2f(m - mnew);
            m = mnew;
            float ps = 0.f;
#pragma unroll
            for (int i = 0; i < 16; ++i) { s0[i] = __builtin_amdgcn_exp2f(s0[i] - mnew); s1[i] = __builtin_amdgcn_exp2f(s1[i] - mnew); ps += s0[i] + s1[i]; }
            l = l * alpha + ps;
#pragma unroll
            for (int i = 0; i < 16; ++i) { o0[i] *= alpha; o1[i] *= alpha; }
            u32x4 pw[4];
#pragma unroll
            for (int q = 0; q < 4; ++q) { pw[0][q] = pk_bf16(s0[2 * q], s0[2 * q + 1]); pw[1][q] = pk_bf16(s0[8 + 2 * q], s0[8 + 2 * q + 1]);
                                          pw[2][q] = pk_bf16(s1[2 * q], s1[2 * q + 1]); pw[3][q] = pk_bf16(s1[8 + 2 * q], s1[8 + 2 * q + 1]); }
            const LAS unsigned char* vb = lds + ATT_V + buf * ATT_TILE + r * KP + 16 * h;
#pragma unroll
            for (int ks = 0; ks < 4; ++ks) {
                const bf16x8 a0 = *(const LAS bf16x8*)(vb + 32 * ks);
                const bf16x8 a1 = *(const LAS bf16x8*)(vb + 32 * KP + 32 * ks);
                const bf16x8 pf = __builtin_bit_cast(bf16x8, pw[ks]);
                o0 = __builtin_amdgcn_mfma_f32_32x32x16_bf16(a0, pf, o0, 0, 0, 0);
                o1 = __builtin_amdgcn_mfma_f32_32x32x16_bf16(a1, pf, o1, 0, 0, 0);
            }
        }
        if (it + 1 < nT) { *(LAS u32x4*)(lds + ATT_K + (buf ^ 1) * ATT_TILE + sdst) = kreg; *(LAS u32x4*)(lds + ATT_V + (buf ^ 1) * ATT_TILE + sdst) = vreg; }
        __syncthreads();
    }
    l += __shfl_xor(l, 32);
    const float inv = 1.f / l;
    bf16_t* og = obuf + (tokbase + qpos) * DM + ocol + 4 * h;
    float qs = 0.f;
#pragma unroll
    for (int g = 0; g < 4; ++g) {
        u32x2 a, c;
        a.x = pk_bf16(o0[4 * g] * inv, o0[4 * g + 1] * inv); a.y = pk_bf16(o0[4 * g + 2] * inv, o0[4 * g + 3] * inv);
        c.x = pk_bf16(o1[4 * g] * inv, o1[4 * g + 1] * inv); c.y = pk_bf16(o1[4 * g + 2] * inv, o1[4 * g + 3] * inv);
        *(u32x2*)(og + 8 * g) = a; *(u32x2*)(og + 32 + 8 * g) = c;
        qs += sq2(a.x) + sq2(a.y) + sq2(c.x) + sq2(c.y);
    }
    qs += __shfl_xor(qs, 32);
    if (h == 0) atomicAdd(sg + tokbase + qpos, (unsigned long long)(qs * 16777216.f));
}

__device__ __forceinline__ void attn_b_unit(LAS unsigned char* lds, const bf16_t* proj, const bf16_t* vt, bf16_t* obuf, int b, int hk, int blk, const float* btab, unsigned long long* sg, bool build_lut) {
    int tid_ = threadIdx.x; asm volatile("" : "+v"(tid_));
    const int tid = tid_, lane = tid & 63, r = lane & 31, h = lane >> 5;
    const int w = __builtin_amdgcn_readfirstlane(tid >> 6);
    const int R0 = 4 * blk, ra = R0 + 2 * (w >> 2), m = w & 3;
    const int rq = ra + (r >> 4), c = 16 * m + (r & 15), qpos = rq * 64 + c;
    const int kc0 = clampi(16 * m - 8, 0, 32);
    const int qcol = QB_OFF + 64 * hk, kcol = KB_OFF + 64 * hk, vslot = 2 + hk, ocol = 512 + 64 * hk;
    const int T0 = clampi(R0 - 4, 0, 120), T1 = clampi(R0 - 1, 0, 120) + 7;
    const int wlo = clampi(ra - 4, 0, 120), whi = clampi(ra - 3, 0, 120) + 7;
    const int rsq = clampi(rq - 4, 0, 120);
    LAS float* bias = (LAS float*)(lds + ATT_BIAS);
    if (build_lut) for (int idx = tid; idx < 16 * 128; idx += 512) { const int dr = idx >> 7, y = idx & 127; bias[idx] = dr < 15 ? btab[(hk * 15 + dr) * 31 + clampi(y - 48, 0, 30)] * LOG2E : NEGBIG; }
    float pen[16];
    { const int cs = clampi(c - 8, 0, 48);
#pragma unroll
      for (int i = 0; i < 16; ++i) { const int kc = kc0 + 16 * (i >> 3) + 8 * h + (i & 7); pen[i] = (kc >= cs && kc < cs + 16) ? 0.f : NEGBIG; } }
    const size_t tokbase = (size_t)b * SEQ;
    const int srow = tid >> 3, sch = tid & 7;
    const bf16_t* kg = proj + (tokbase + srow) * INW + kcol + sch * 8;
    const bf16_t* vg = vt + ((size_t)(b * NVS + vslot) * 64 + srow) * SEQ + sch * 8;
    const unsigned sdst = srow * KP + sch * 16;
    u32x4 kreg, vreg;
    const bf16_t* qg = proj + (tokbase + qpos) * INW + qcol + 8 * h;
    bf16x8 qf[4];
#pragma unroll
    for (int ks = 0; ks < 4; ++ks) qf[ks] = *(const bf16x8*)(qg + 16 * ks);
    float mrun = -1e29f, l = 0.f;
    f32x16 o0, o1;
#pragma unroll
    for (int i = 0; i < 16; ++i) { o0[i] = 0.f; o1[i] = 0.f; }
    const int pr = (r & ~12) | ((r & 4) << 1) | ((r & 8) >> 1);
    const int nT = T1 - T0 + 1;
    kreg = *(const u32x4*)(kg + (size_t)(T0 * 64) * INW); vreg = *(const u32x4*)(vg + T0 * 64);
    *(LAS u32x4*)(lds + ATT_K + sdst) = kreg; *(LAS u32x4*)(lds + ATT_V + sdst) = vreg;
    __syncthreads();
    for (int it = 0; it < nT; ++it) {
        const int T = T0 + it, buf = it & 1;
        if (it + 1 < nT) { kreg = *(const u32x4*)(kg + (size_t)((T + 1) * 64) * INW); vreg = *(const u32x4*)(vg + (T + 1) * 64); }
        if (T >= wlo && T <= whi) {
            const LAS unsigned char* kb = lds + ATT_K + buf * ATT_TILE + (kc0 + pr) * KP + 16 * h;
            f32x16 s0;
#pragma unroll
            for (int i = 0; i < 16; ++i) s0[i] = 0.f;
#pragma unroll
            for (int ks = 0; ks < 4; ++ks) s0 = __builtin_amdgcn_mfma_f32_32x32x16_bf16(*(const LAS bf16x8*)(kb + 32 * ks), qf[ks], s0, 0, 0, 0);
            const int dr = (T >= rsq && T < rsq + 8) ? T - rq + 7 : 15;
            const LAS float* bh = bias + dr * 128 + (kc0 + 8 * h - c + 63);
#pragma unroll
            for (int i = 0; i < 16; ++i) s0[i] = (s0[i] * C2 + bh[16 * (i >> 3) + (i & 7)]) + pen[i];
            float mx = s0[0];
#pragma unroll
            for (int i = 1; i < 16; ++i) mx = fmaxf(mx, s0[i]);
            mx = fmaxf(mx, __shfl_xor(mx, 32));
            const float mnew = fmaxf(mrun, mx);
            const float alpha = __builtin_amdgcn_exp2f(mrun - mnew);
            mrun = mnew;
            float ps = 0.f;
#pragma unroll
            for (int i = 0; i < 16; ++i) { s0[i] = __builtin_amdgcn_exp2f(s0[i] - mnew); ps += s0[i]; }
            l = l * alpha + ps;
#pragma unroll
            for (int i = 0; i < 16; ++i) { o0[i] *= alpha; o1[i] *= alpha; }
            u32x4 pw[2];
#pragma unroll
            for (int q = 0; q < 4; ++q) { pw[0][q] = pk_bf16(s0[2 * q], s0[2 * q + 1]); pw[1][q] = pk_bf16(s0[8 + 2 * q], s0[8 + 2 * q + 1]); }
            const LAS unsigned char* vb = lds + ATT_V + buf * ATT_TILE + r * KP + 2 * kc0 + 16 * h;
#pragma unroll
            for (int ks = 0; ks < 2; ++ks) {
                const bf16x8 a0 = *(const LAS bf16x8*)(vb + 32 * ks), a1 = *(const LAS bf16x8*)(vb + 32 * KP + 32 * ks);
                const bf16x8 pf = __builtin_bit_cast(bf16x8, pw[ks]);
                o0 = __builtin_amdgcn_mfma_f32_32x32x16_bf16(a0, pf, o0, 0, 0, 0);
                o1 = __builtin_amdgcn_mfma_f32_32x32x16_bf16(a1, pf, o1, 0, 0, 0);
            }
        }
        if (it + 1 < nT) { *(LAS u32x4*)(lds + ATT_K + (buf ^ 1) * ATT_TILE + sdst) = kreg; *(LAS u32x4*)(lds + ATT_V + (buf ^ 1) * ATT_TILE + sdst) = vreg; }
        __syncthreads();
    }
    l += __shfl_xor(l, 32);
    const float inv = 1.f / l;
    bf16_t* og = obuf + (tokbase + qpos) * DM + ocol + 4 * h;
    float qs = 0.f;
#pragma unroll
    for (int g = 0; g < 4; ++g) {
        u32x2 a, cc;
        a.x = pk_bf16(o0[4 * g] * inv, o0[4 * g + 1] * inv); a.y = pk_bf16(o0[4 * g + 2] * inv, o0[4 * g + 3] * inv);
        cc.x = pk_bf16(o1[4 * g] * inv, o1[4 * g + 1] * inv); cc.y = pk_bf16(o1[4 * g + 2] * inv, o1[4 * g + 3] * inv);
        *(u32x2*)(og + 8 * g) = a; *(u32x2*)(og + 32 + 8 * g) = cc;
        qs += sq2(a.x) + sq2(a.y) + sq2(cc.x) + sq2(cc.y);
    }
    qs += __shfl_xor(qs, 32);
    if (h == 0) atomicAdd(sg + tokbase + qpos, (unsigned long long)(qs * 16777216.f));
}

__device__ __forceinline__ void attn_c_unit(LAS unsigned char* lds, const bf16_t* proj, const bf16_t* vt, bf16_t* obuf, int b, int hk, int blk, float mref, unsigned long long* sg) {
    int tid_ = threadIdx.x; asm volatile("" : "+v"(tid_));
    const int tid = tid_, lane = tid & 63, r = lane & 31, h = lane >> 5;
    const int w = __builtin_amdgcn_readfirstlane(tid >> 6);
    const int qhead = 4 * hk + (w >> 1), qpos = blk * 128 + 64 * (w & 1) + r, qcol = QC_OFF + 64 * qhead, kcol = KC_OFF + 64 * hk, vslot = 10 + hk, ocol = 1024 + 64 * qhead;
    const size_t tokbase = (size_t)b * SEQ;
    const int srow = tid >> 3, sch = tid & 7;
    const bf16_t* kg = proj + (tokbase + srow) * INW + kcol + sch * 8;
    const bf16_t* vg = vt + ((size_t)(b * NVS + vslot) * 64 + srow) * SEQ + sch * 8;
    const unsigned sdst = srow * KP + sch * 16;
    u32x4 kreg, vreg;
    const bf16_t* qg = proj + (tokbase + qpos) * INW + qcol + 8 * h;
    bf16x8 qf[2][4];
#pragma unroll
    for (int j = 0; j < 2; ++j)
#pragma unroll
        for (int ks = 0; ks < 4; ++ks) qf[j][ks] = *(const bf16x8*)(qg + (size_t)(32 * j) * INW + 16 * ks);
    f32x16 negm;
#pragma unroll
    for (int i = 0; i < 16; ++i) negm[i] = 0.f;
    float l0 = 0.f, l1 = 0.f;
    f32x16 o00, o01, o10, o11;
#pragma unroll
    for (int i = 0; i < 16; ++i) { o00[i] = 0.f; o01[i] = 0.f; o10[i] = 0.f; o11[i] = 0.f; }
    const int pr = (r & ~12) | ((r & 4) << 1) | ((r & 8) >> 1);
    constexpr int nT = SEQ / 64;
    constexpr int CK = 0, CV = 4 * ATT_TILE;
#pragma unroll
    for (int i = 0; i < 2; ++i) { kreg = *(const u32x4*)(kg + (size_t)(i * 64) * INW); vreg = *(const u32x4*)(vg + i * 64);
        *(LAS u32x4*)(lds + CK + i * ATT_TILE + sdst) = kreg; *(LAS u32x4*)(lds + CV + i * ATT_TILE + sdst) = vreg; }
    __syncthreads();
    for (int it = 0; it < nT; ++it) {
        const int buf = it & 3;
        if (it + 2 < nT) { kreg = *(const u32x4*)(kg + (size_t)((it + 2) * 64) * INW); vreg = *(const u32x4*)(vg + (it + 2) * 64); }
        const LAS unsigned char* kb = lds + CK + buf * ATT_TILE + pr * KP + 16 * h;
        f32x16 s00, s01, s10, s11;
        {
            const bf16x8 a0 = *(const LAS bf16x8*)(kb), a1 = *(const LAS bf16x8*)(kb + 32 * KP);
            s00 = __builtin_amdgcn_mfma_f32_32x32x16_bf16(a0, qf[0][0], negm, 0, 0, 0);
            s10 = __builtin_amdgcn_mfma_f32_32x32x16_bf16(a0, qf[1][0], negm, 0, 0, 0);
            s01 = __builtin_amdgcn_mfma_f32_32x32x16_bf16(a1, qf[0][0], negm, 0, 0, 0);
            s11 = __builtin_amdgcn_mfma_f32_32x32x16_bf16(a1, qf[1][0], negm, 0, 0, 0);
        }
#pragma unroll
        for (int ks = 1; ks < 4; ++ks) {
            const bf16x8 a0 = *(const LAS bf16x8*)(kb + 32 * ks), a1 = *(const LAS bf16x8*)(kb + 32 * KP + 32 * ks);
            s00 = __builtin_amdgcn_mfma_f32_32x32x16_bf16(a0, qf[0][ks], s00, 0, 0, 0);
            s10 = __builtin_amdgcn_mfma_f32_32x32x16_bf16(a0, qf[1][ks], s10, 0, 0, 0);
            s01 = __builtin_amdgcn_mfma_f32_32x32x16_bf16(a1, qf[0][ks], s01, 0, 0, 0);
            s11 = __builtin_amdgcn_mfma_f32_32x32x16_bf16(a1, qf[1][ks], s11, 0, 0, 0);
        }
        u32x4 pw0[4], pw1[4];
        {
            float ps = 0.f;
#pragma unroll
            for (int i = 0; i < 16; ++i) { s00[i] = __builtin_amdgcn_exp2f(s00[i]); s01[i] = __builtin_amdgcn_exp2f(s01[i]); ps += s00[i] + s01[i]; }
            l0 += ps;
#pragma unroll
            for (int q = 0; q < 4; ++q) { pw0[0][q] = pk_bf16(s00[2 * q], s00[2 * q + 1]); pw0[1][q] = pk_bf16(s00[8 + 2 * q], s00[8 + 2 * q + 1]);
                                          pw0[2][q] = pk_bf16(s01[2 * q], s01[2 * q + 1]); pw0[3][q] = pk_bf16(s01[8 + 2 * q], s01[8 + 2 * q + 1]); }
        }
        {
            float ps = 0.f;
#pragma unroll
            for (int i = 0; i < 16; ++i) { s10[i] = __builtin_amdgcn_exp2f(s10[i]); s11[i] = __builtin_amdgcn_exp2f(s11[i]); ps += s10[i] + s11[i]; }
            l1 += ps;
#pragma unroll
            for (int q = 0; q < 4; ++q) { pw1[0][q] = pk_bf16(s10[2 * q], s10[2 * q + 1]); pw1[1][q] = pk_bf16(s10[8 + 2 * q], s10[8 + 2 * q + 1]);
                                          pw1[2][q] = pk_bf16(s11[2 * q], s11[2 * q + 1]); pw1[3][q] = pk_bf16(s11[8 + 2 * q], s11[8 + 2 * q + 1]); }
        }
        const LAS unsigned char* vb = lds + CV + buf * ATT_TILE + r * KP + 16 * h;
#pragma unroll
        for (int ks = 0; ks < 4; ++ks) {
            const bf16x8 a0 = *(const LAS bf16x8*)(vb + 32 * ks), a1 = *(const LAS bf16x8*)(vb + 32 * KP + 32 * ks);
            const bf16x8 p0 = __builtin_bit_cast(bf16x8, pw0[ks]), p1 = __builtin_bit_cast(bf16x8, pw1[ks]);
            o00 = __builtin_amdgcn_mfma_f32_32x32x16_bf16(a0, p0, o00, 0, 0, 0);
            o10 = __builtin_amdgcn_mfma_f32_32x32x16_bf16(a0, p1, o10, 0, 0, 0);
            o01 = __builtin_amdgcn_mfma_f32_32x32x16_bf16(a1, p0, o01, 0, 0, 0);
            o11 = __builtin_amdgcn_mfma_f32_32x32x16_bf16(a1, p1, o11, 0, 0, 0);
        }
        if (it + 2 < nT) { *(LAS u32x4*)(lds + CK + (buf ^ 2) * ATT_TILE + sdst) = kreg; *(LAS u32x4*)(lds + CV + (buf ^ 2) * ATT_TILE + sdst) = vreg; }
        if (it & 1) __syncthreads();
    }
    l0 += __shfl_xor(l0, 32); l1 += __shfl_xor(l1, 32);
    const float inv0 = 1.f / l0, inv1 = 1.f / l1;
    bf16_t* og = obuf + (tokbase + qpos) * DM + ocol + 4 * h;
    float qs0 = 0.f, qs1 = 0.f;
#pragma unroll
    for (int g = 0; g < 4; ++g) {
        u32x2 a, c;
        a.x = pk_bf16(o00[4 * g] * inv0, o00[4 * g + 1] * inv0); a.y = pk_bf16(o00[4 * g + 2] * inv0, o00[4 * g + 3] * inv0);
        c.x = pk_bf16(o01[4 * g] * inv0, o01[4 * g + 1] * inv0); c.y = pk_bf16(o01[4 * g + 2] * inv0, o01[4 * g + 3] * inv0);
        *(u32x2*)(og + 8 * g) = a; *(u32x2*)(og + 32 + 8 * g) = c;
        qs0 += sq2(a.x) + sq2(a.y) + sq2(c.x) + sq2(c.y);
        a.x = pk_bf16(o10[4 * g] * inv1, o10[4 * g + 1] * inv1); a.y = pk_bf16(o10[4 * g + 2] * inv1, o10[4 * g + 3] * inv1);
        c.x = pk_bf16(o11[4 * g] * inv1, o11[4 * g + 1] * inv1); c.y = pk_bf16(o11[4 * g + 2] * inv1, o11[4 * g + 3] * inv1);
        *(u32x2*)(og + (size_t)32 * DM + 8 * g) = a; *(u32x2*)(og + (size_t)32 * DM + 32 + 8 * g) = c;
        qs1 += sq2(a.x) + sq2(a.y) + sq2(c.x) + sq2(c.y);
    }
    qs0 += __shfl_xor(qs0, 32); qs1 += __shfl_xor(qs1, 32);
    if (h == 0) { atomicAdd(sg + tokbase + qpos, (unsigned long long)(qs0 * 16777216.f)); atomicAdd(sg + tokbase + qpos + 32, (unsigned long long)(qs1 * 16777216.f)); }
}

__device__ __forceinline__ void attn_phase(CP P, LAS unsigned char* lds, int layer) {
    const bf16_t* proj = (const bf16_t*)(P->ws + WS_PROJ); const bf16_t* vt = (const bf16_t*)(P->ws + WS_VT); bf16_t* obuf = (bf16_t*)(P->ws + WS_O);
    const int G = gridDim.x;
    unsigned long long* sgA = (unsigned long long*)(P->ws + WS_SG) + (size_t)(3 * layer) * MTOK; unsigned long long* sgB = sgA + MTOK; unsigned long long* sgC = sgB + MTOK;
    {
        float gq = 0.f, gk = 0.f;
        for (int d = 0; d < 64; ++d) { gq = fmaxf(gq, fabsf(P->c_q_gain[layer * 64 + d])); gk = fmaxf(gk, fabsf(P->c_k_gain[layer * 64 + d])); }
        const float bound = 64.f * C2 * gq * gk;
        if (bound < 60.f) {
            for (int u = blockIdx.x; u < 8 * 64; u += G) attn_c_unit(lds, proj, vt, obuf, (u & 7) >> 2, u & 3, u >> 3, 0.f, sgC);
        } else {
            for (int u = blockIdx.x; u < 8 * 128; u += G) attn_unit<2>(lds, proj, vt, obuf, (u & 7) >> 2, u & 3, u >> 3, nullptr, nullptr, sgC, false);
        }
    }
    { int prev = -1; for (int u = blockIdx.x; u < 4 * 128; u += G) { attn_unit<0>(lds, proj, vt, obuf, (u & 3) >> 1, u & 1, u >> 2, P->t5, P->a_sink + layer * 8, sgA, (u & 1) != prev); prev = u & 1; } }
    { int prev = -1; for (int u = blockIdx.x; u < 16 * 32; u += G) { attn_b_unit(lds, proj, vt, obuf, (u & 15) >> 3, u & 7, u >> 4, P->b_rpb + (size_t)layer * 8 * 15 * 31, sgB, (u & 7) != prev); prev = u & 7; } }
}

__device__ __forceinline__ void mixnorm_phase(CP P, int layer) {
    int tid_ = threadIdx.x; asm volatile("" : "+v"(tid_));
    const int lane = tid_ & 63, wave = __builtin_amdgcn_readfirstlane(tid_ >> 6);
    const int gw = blockIdx.x * 8 + wave, NGW = gridDim.x * 8;
    const bf16_t* obuf = (const bf16_t*)(P->ws + WS_O); bf16_t* mix = (bf16_t*)(P->ws + WS_MIX);
    f32x4 g[4][2];
#pragma unroll
    for (int j = 0; j < 4; ++j) {
        const float* gp = (j == 0) ? P->og_a + layer * 512 + lane * 8 : (j == 1) ? P->og_b + layer * 512 + lane * 8 : P->og_c + layer * 1024 + (j - 2) * 512 + lane * 8;
        g[j][0] = *(const f32x4*)gp; g[j][1] = *(const f32x4*)(gp + 4);
    }
    for (int tok = gw; tok < MTOK; tok += NGW) {
        const u32x4* src = (const u32x4*)(obuf + (size_t)tok * DM) + lane;
        float v[4][8]; float ss[4];
#pragma unroll
        for (int j = 0; j < 4; ++j) { const u32x4 raw = src[64 * j]; ss[j] = 0.f;
#pragma unroll
            for (int q = 0; q < 4; ++q) { v[j][2 * q] = bf_lo(raw[q]); v[j][2 * q + 1] = bf_hi(raw[q]); ss[j] += v[j][2 * q] * v[j][2 * q] + v[j][2 * q + 1] * v[j][2 * q + 1]; } }
        const float sa = wave_sum(ss[0]), sb = wave_sum(ss[1]), sc = wave_sum(ss[2] + ss[3]);
        float rs[4]; rs[0] = rsqrtf(sa * (1.f / 512.f) + EPS); rs[1] = rsqrtf(sb * (1.f / 512.f) + EPS); rs[2] = rsqrtf(sc * (1.f / 1024.f) + EPS); rs[3] = rs[2];
        u32x4* dst = (u32x4*)(mix + (size_t)tok * DM) + lane;
#pragma unroll
        for (int j = 0; j < 4; ++j) { u32x4 wv;
            wv.x = pk_bf16(v[j][0] * rs[j] * g[j][0].x, v[j][1] * rs[j] * g[j][0].y); wv.y = pk_bf16(v[j][2] * rs[j] * g[j][0].z, v[j][3] * rs[j] * g[j][0].w);
            wv.z = pk_bf16(v[j][4] * rs[j] * g[j][1].x, v[j][5] * rs[j] * g[j][1].y); wv.w = pk_bf16(v[j][6] * rs[j] * g[j][1].z, v[j][7] * rs[j] * g[j][1].w);
            dst[64 * j] = wv; }
    }
}

typedef unsigned v4u __attribute__((ext_vector_type(4)));
#define XB_TMO      128
#define XB_XCNT(j)  (256  + 64 * (j))
#define XB_XSUB(j)  (1280 + 64 * (j))
#define XB_XGEN(j)  (2304 + 64 * (j))
#define XB_TOP      3328
#define XB_TOPGEN   3392
#define XCD_BAR_WORDS 3456
#define XB_SPIN_CAP (1u << 22)

__device__ __forceinline__ unsigned xb_ld(unsigned* p)              { return __hip_atomic_load(p, __ATOMIC_RELAXED, __HIP_MEMORY_SCOPE_AGENT); }
__device__ __forceinline__ unsigned xb_add(unsigned* p, unsigned v) { return __hip_atomic_fetch_add(p, v, __ATOMIC_RELAXED, __HIP_MEMORY_SCOPE_AGENT); }
__device__ __forceinline__ unsigned xb_xcc_id() { return (unsigned)__builtin_amdgcn_s_getreg((3 << 11) | 20) & 0xFu; }
#define XB_SPIN(cond, bar) do { unsigned _sp = 0; while (cond) { __builtin_amdgcn_s_sleep(1); \
    if ((++_sp & 255u) == 0u) { if (xb_ld(&(bar)[XB_TMO])) break; if (_sp > XB_SPIN_CAP) { atomicAdd(&(bar)[XB_TMO], 1u); break; } } } } while (0)

struct XcdBarrier {
    unsigned* bar; unsigned x;
    volatile LAS unsigned* st;
};

__device__ __forceinline__ XcdBarrier xcd_barrier_post(unsigned* bar, volatile LAS unsigned* st) {
    XcdBarrier b; b.bar = bar; b.x = xb_xcc_id(); b.st = st;
    if (threadIdx.x == 0) (void)xb_add(&bar[XB_XCNT(b.x)], 1u);
    return b;
}
__device__ __forceinline__ void xcd_barrier_complete(unsigned* bar, unsigned x, unsigned& nloc, unsigned& nx) {
    const unsigned G = gridDim.x * gridDim.y * gridDim.z;
    unsigned sum, cnt, mine, sp = 0u;
    for (;;) {
        sum = 0u; cnt = 0u; mine = 0u;
#pragma unroll
        for (unsigned j = 0; j < 16; ++j) { const unsigned c = xb_ld(&bar[XB_XCNT(j)]); sum += c; cnt += (c > 0u) ? 1u : 0u; mine = (j == x) ? c : mine; }
        if (sum == G) break;
        __builtin_amdgcn_s_sleep(1);
        if ((++sp & 255u) == 0u) { if (xb_ld(&bar[XB_TMO])) break; if (sp > XB_SPIN_CAP) { atomicAdd(&bar[XB_TMO], 1u); break; } }
    }
    nloc = mine > 0u ? mine : 1u; nx = cnt > 0u ? cnt : 1u;
}

__device__ __forceinline__ void xcd_barrier(const XcdBarrier& b) {
    asm volatile("s_waitcnt vmcnt(0)" ::: "memory");
    __syncthreads();
    if (threadIdx.x == 0) {
        unsigned* bar = b.bar;
        __builtin_amdgcn_s_waitcnt(0);
        unsigned nloc = b.st[0], nx = b.st[1];
        if (nloc == 0u) { xcd_barrier_complete(bar, b.x, nloc, nx); b.st[0] = nloc; b.st[1] = nx; }
        const unsigned old = xb_add(&bar[XB_XSUB(b.x)], 1u);
        const unsigned gen = old / nloc;
        if (old + 1u == (gen + 1u) * nloc) {
            __builtin_amdgcn_fence(__ATOMIC_RELEASE, "agent");
            asm volatile("s_waitcnt vmcnt(0)" ::: "memory");
            const unsigned og = xb_add(&bar[XB_TOP], 1u);
            const unsigned tg = og / nx;
            if (og + 1u == (tg + 1u) * nx) xb_add(&bar[XB_TOPGEN], 1u);
            else XB_SPIN(xb_ld(&bar[XB_TOPGEN]) == tg, bar);
            __builtin_amdgcn_fence(__ATOMIC_ACQUIRE, "agent");
            xb_add(&bar[XB_XGEN(b.x)], 1u);
            asm volatile("s_waitcnt vmcnt(0)" ::: "memory");
        } else {
            XB_SPIN(xb_ld(&bar[XB_XGEN(b.x)]) == gen, bar);
            __builtin_amdgcn_fence(__ATOMIC_ACQUIRE, "agent");
            asm volatile("s_waitcnt vmcnt(0)" ::: "memory");
        }
    }
    __syncthreads();
}

__global__ void __launch_bounds__(512, 2) hymba_fwd(Params Parg) {
    extern __shared__ __attribute__((aligned(16))) unsigned char lds_raw[];
    LAS unsigned char* lds = (LAS unsigned char*)lds_raw;
    cg::grid_group grid = cg::this_grid();
    volatile LAS unsigned* bar_st = (volatile LAS unsigned*)(lds + LDS_BYTES - 64);
    if (threadIdx.x < 2) bar_st[threadIdx.x] = 0u;
    __syncthreads();
    (void)xcd_barrier_post((unsigned*)(PP()->ws + WS_BAR), bar_st);
#define BUILD_RSTAB(S_, ssptr) do { pg8::Unit uu_; LAS float* t_ = (LAS float*)(lds + 131072); int tb_ = threadIdx.x; asm volatile("" : "+v"(tb_)); \
        _Pragma("unroll 1") for (int ui_ = 0; ui_ < 15 && (S_).next(ui_, uu_); ++ui_) \
            for (int rl_ = tb_; rl_ < 256; rl_ += 512) t_[ui_ * 256 + rl_] = rsqrtf((float)(ssptr)[(size_t)uu_.pm * 256 + rl_] * (1.f / (2048.f * 16777216.f)) + EPS); \
        __syncthreads(); } while (0)
#define GRID_BAR() do { XcdBarrier b_; b_.bar = (unsigned*)(PP()->ws + WS_BAR); b_.x = xb_xcc_id(); b_.st = bar_st; xcd_barrier(b_); } while (0)

    weights_phase(PP(), lds);
    { CP P = PP(); xinit_phase(P->x, (bf16_t*)(P->ws + WS_H), (unsigned long long*)(P->ws + WS_SS)); }
    grid.sync();
    for (int layer = 0; layer < DEPTH; ++layer) {
        {
            CP P = PP(); unsigned char* ws = P->ws;
            pg8::Gemm g{(const bf16_t*)(ws + WS_H), (const bf16_t*)(ws + WS_WIN + layer * SZ_WIN), MTOK, INW, DM}; pg8::StaticOrder S; S.init(MTOK, INW, gridDim.x, blockIdx.x);
            BUILD_RSTAB(S, (const unsigned long long*)(ws + WS_SS) + (size_t)(2 * layer) * MTOK);
            pg8::EpiInProj E{(bf16_t*)(ws + WS_PROJ), (bf16_t*)(ws + WS_VT), (const LAS float*)(lds + 131072), P->c_q_gain + layer * 64, P->c_k_gain + layer * 64};
            pg8::gemm_phase<pg8::EpiInProj, pg8::StaticOrder, true, true>(lds, g, S, E);
        }
        weights_deferred(PP(), layer);
        GRID_BAR();
        attn_phase(PP(), lds, layer);
        GRID_BAR();
        {
            CP P = PP(); unsigned char* ws = P->ws;
            pg8::Gemm g{(const bf16_t*)(ws + WS_O), (const bf16_t*)(ws + WS_WO + layer * SZ_WO), MTOK, DM, DM}; pg8::StaticOrder S; S.init(MTOK, DM, gridDim.x, blockIdx.x);
            LAS float* tab = (LAS float*)(lds + 131072);
            {
                const unsigned long long* sgA = (const unsigned long long*)(ws + WS_SG) + (size_t)(3 * layer) * MTOK;
                pg8::Unit uu;
                int tb_ = threadIdx.x; asm volatile("" : "+v"(tb_));
#pragma unroll 1
                for (int ui = 0; ui < 4 && S.next(ui, uu); ++ui)
                    for (int rl = tb_; rl < 256; rl += 512) { const size_t tok = (size_t)uu.pm * 256 + rl;
                        const float ra = rsqrtf((float)sgA[tok] * (1.f / (512.f * 16777216.f)) + EPS), rb = rsqrtf((float)sgA[MTOK + tok] * (1.f / (512.f * 16777216.f)) + EPS),
                                    rc = rsqrtf((float)sgA[2 * MTOK + tok] * (1.f / (1024.f * 16777216.f)) + EPS);
                        tab[(ui * 3 + 0) * 256 + rl] = ra / rb; tab[(ui * 3 + 1) * 256 + rl] = rb / rc; tab[(ui * 3 + 2) * 256 + rl] = rc; }
                __syncthreads();
            }
            pg8::EpiResBf16 E{(bf16_t*)(ws + WS_H), DM, (unsigned long long*)(ws + WS_SS) + (size_t)(2 * layer + 1) * MTOK};
            pg8::MixHook Hk{tab};
            pg8::gemm_phase<pg8::EpiResBf16, pg8::StaticOrder, true, true, pg8::MixHook>(lds, g, S, E, Hk);
        }
        GRID_BAR();
        {
            CP P = PP(); unsigned char* ws = P->ws;
            pg8::Gemm g{(const bf16_t*)(ws + WS_H), (const bf16_t*)(ws + WS_WUP + layer * SZ_WUP), MTOK, DFF, DM}; pg8::StaticOrder S; S.init(MTOK, DFF, gridDim.x, blockIdx.x);
            BUILD_RSTAB(S, (const unsigned long long*)(ws + WS_SS) + (size_t)(2 * layer + 1) * MTOK);
            pg8::EpiBf16<2> E{(bf16_t*)(ws + WS_U), DFF, (const LAS float*)(lds + 131072)};
            pg8::gemm_phase<pg8::EpiBf16<2>, pg8::StaticOrder, true, true>(lds, g, S, E);
        }
        GRID_BAR();
        {
            CP P = PP(); unsigned char* ws = P->ws;
            pg8::Gemm g{(const bf16_t*)(ws + WS_U), (const bf16_t*)(ws + WS_WDN + layer * SZ_WDN), MTOK, DM, DFF}; pg8::StaticOrder S; S.init(MTOK, DM, gridDim.x, blockIdx.x);
            pg8::EpiResBf16 E{(bf16_t*)(ws + WS_H), DM, (unsigned long long*)(ws + WS_SS) + (size_t)(2 * layer + 2) * MTOK};
            pg8::gemm_phase<pg8::EpiResBf16, pg8::StaticOrder, true, true, pg8::NoHook, true>(lds, g, S, E);
        }
        GRID_BAR();
    }
    { CP P = PP(); final_phase((const bf16_t*)(P->ws + WS_H), P->out, P->norm_final, (const unsigned long long*)(P->ws + WS_SS) + (size_t)(2 * DEPTH) * MTOK); }
}

extern "C" void kernel_launch(void* const* d_in, const int* in_sizes, int n_in, void* d_out, int out_size, void* d_ws, size_t ws_size, hipStream_t stream) {
    static int grid = 0;
    if (grid == 0) {
        if (n_in != 16 || in_sizes[0] != MTOK * DM || out_size != MTOK * DM || ws_size < WS_END) {
            fprintf(stderr, "kernel_launch: unexpected shapes (n_in %d, in0 %d, out %d, ws %zu need %zu)\n", n_in, n_in > 0 ? in_sizes[0] : -1, out_size, ws_size, (size_t)WS_END); grid = -1; return; }
        int dev = 0, cus = 0, per_cu = 0;
        hipGetDevice(&dev); hipDeviceGetAttribute(&cus, hipDeviceAttributeMultiprocessorCount, dev);
        if (hipFuncSetAttribute((const void*)hymba_fwd, hipFuncAttributeMaxDynamicSharedMemorySize, LDS_BYTES) != hipSuccess) fprintf(stderr, "kernel_launch: hipFuncSetAttribute failed\n");
        if (hipOccupancyMaxActiveBlocksPerMultiprocessor(&per_cu, (const void*)hymba_fwd, 512, LDS_BYTES) != hipSuccess || per_cu < 1) { fprintf(stderr, "kernel_launch: occupancy query gave %d\n", per_cu); per_cu = 1; }
        (void)hipGetLastError();
        grid = cus * per_cu;
        if (grid < 192) { fprintf(stderr, "kernel_launch: grid %d too small for this build (the LDS row-factor tables hold 4 out-projection / 15 up-projection tiles per workgroup)\n", grid); grid = -1; return; }
    }
    if (grid < 0) return;
    Params p{};
    p.x = (const float*)d_in[0]; p.norm_mix = (const float*)d_in[1]; p.w_in = (const float*)d_in[2]; p.a_sink = (const float*)d_in[3]; p.t5 = (const float*)d_in[4];
    p.b_rpb = (const float*)d_in[5]; p.c_q_gain = (const float*)d_in[6]; p.c_k_gain = (const float*)d_in[7]; p.og_a = (const float*)d_in[8]; p.og_b = (const float*)d_in[9];
    p.og_c = (const float*)d_in[10]; p.w_o = (const float*)d_in[11]; p.norm_mlp = (const float*)d_in[12]; p.w_up = (const float*)d_in[13]; p.w_down = (const float*)d_in[14];
    p.norm_final = (const float*)d_in[15]; p.out = (float*)d_out; p.ws = (unsigned char*)d_ws;
    if (hipMemsetAsync((char*)d_ws + WS_BAR, 0, 16384, stream) != hipSuccess) { fprintf(stderr, "kernel_launch: memset of the barrier words failed\n"); return; }
    void* args[] = {&p};
    hipError_t e = hipLaunchCooperativeKernel((const void*)hymba_fwd, dim3(grid), dim3(512), args, LDS_BYTES, stream);
    if (e != hipSuccess) fprintf(stderr, "kernel_launch: cooperative launch failed: %s (grid %d)\n", hipGetErrorString(e), grid);
}
```

```cpp
#include <hip/hip_runtime.h>
#include <hip/hip_cooperative_groups.h>
#include <cstdio>
#include <cstdint>
namespace cg = cooperative_groups;
namespace pg8 {
#define PG8_LAS __attribute__((address_space(3)))
typedef unsigned short bf16_t;
typedef short bf16x8 __attribute__((ext_vector_type(8)));
typedef float f32x4 __attribute__((ext_vector_type(4)));
typedef unsigned u32x4 __attribute__((ext_vector_type(4)));
constexpr int BM = 256, BK = 64, HALF = 128, HTB = HALF * BK * 2  , STAGE_BYTES = 8 * HTB, NXCD = 8, WGM = 8;

__host__ __device__ __forceinline__ int lds_byte(int r, int c) { const int st = (r >> 4) * 2 + (c >> 5), rr = r & 15, cc = c & 31, ob = rr * 64 + cc * 2; return st * 1024 + (ob ^ (((ob >> 9) & 1) << 5)); }
__host__ __device__ __forceinline__ void stage_rc(int b, int& R, int& C) { const int st = b / 1024, sb = b % 1024, swz = sb ^ (((sb >> 9) & 1) << 5); R = (st >> 1) * 16 + swz / 64; C = (st & 1) * 32 + (swz % 64) / 2; }
__host__ __device__ __forceinline__ int perm32(int rho) { const int n = rho >> 4, i = rho & 15; return 8 * (i >> 2) + 4 * n + (i & 3); }

struct Unit { int pm, pn; };
struct Gemm { const bf16_t* A; const bf16_t* Bt; int M, N, K; };

struct StaticOrder {
    int nM, nN, nwg, G, c;
    __host__ __device__ void init(int M, int N, int G_, int c_) { nM = M / BM; nN = N / BM; nwg = nM * nN; G = G_; c = c_; }
    __host__ __device__ bool next(int i, Unit& u) const {
        const long L = (long)i * G + c; if (L >= nwg) return false;
        int wgid = (int)L; { const int q = nwg / NXCD, r = nwg % NXCD, xcd = wgid % NXCD, off = wgid / NXCD; wgid = (xcd < r ? xcd * (q + 1) : r * (q + 1) + (xcd - r) * q) + off; }
        const int nig = WGM * nN, gid = wgid / nig, fm = gid * WGM, gsz = (nM - fm) < WGM ? (nM - fm) : WGM;
        u.pm = fm + ((wgid % nig) % gsz); u.pn = (wgid % nig) / gsz; return true;
    }
    __device__ __forceinline__ void a_ready(const Unit&) const {}
    __device__ __forceinline__ void done(const Unit&) const {}
};

typedef float f32x2_t __attribute__((ext_vector_type(2))); typedef __bf16 bf16x2_t __attribute__((ext_vector_type(2)));
__device__ __forceinline__ unsigned cvt_pk_bf16(float lo, float hi) { f32x2_t v = {lo, hi}; bf16x2_t b = __builtin_convertvector(v, bf16x2_t); return __builtin_bit_cast(unsigned, b); }

template <int ACT  > struct EpiBf16 {
    static constexpr bool PERM = true, AFTER_DRAIN = false;
    bf16_t* O; int ldc; const PG8_LAS float* rstab;
    __device__ __forceinline__ void operator()(const f32x4 (&acc)[2][2][4][2], const Unit& u, int wr, int wc, int fr, int fq, int ui) const {
        const int row0 = u.pm * BM + wr * 64 + fr; const int col0 = u.pn * BM + wc * 32 + 8 * fq;
#pragma unroll
        for (int ai = 0; ai < 2; ++ai)
#pragma unroll
            for (int m = 0; m < 4; ++m) { const int row = row0 + ai * HALF + m * 16; bf16_t* rowp = O + (size_t)row * ldc + col0;
                const float rs = rstab[ui * 256 + wr * 64 + fr + ai * HALF + m * 16];
#pragma unroll
                for (int bj = 0; bj < 2; ++bj) { f32x4 v0 = acc[ai][bj][m][0] * rs, v1 = acc[ai][bj][m][1] * rs;
                    if (ACT == 2) {
#pragma unroll
                        for (int e = 0; e < 4; ++e) { const float a = fmaxf(v0[e], 0.f), b = fmaxf(v1[e], 0.f); v0[e] = a * a; v1[e] = b * b; } }
                    u32x4 w; w.x = cvt_pk_bf16(v0[0], v0[1]); w.y = cvt_pk_bf16(v0[2], v0[3]); w.z = cvt_pk_bf16(v1[0], v1[1]); w.w = cvt_pk_bf16(v1[2], v1[3]);
                    *(u32x4*)(rowp + bj * HALF) = w; } }
    }
};
struct EpiInProj {
    static constexpr bool PERM = true, AFTER_DRAIN = false;
    bf16_t* O; bf16_t* VT; const PG8_LAS float* rstab; const float* qgain; const float* kgain;
    __device__ __forceinline__ void operator()(const f32x4 (&acc)[2][2][4][2], const Unit& u, int wr, int wc, int fr, int fq, int ui) const {
        constexpr int LDC = 3840, SEQL = 8192;
        const int pn = u.pn, row0 = u.pm * BM + wr * 64 + fr, colh = pn * BM + 64 * wc;
        int mode = 0, vslot = 0;
        if (pn >= 9 && pn <= 12) mode = 1; else if (pn == 13) mode = 2; else if (pn == 14) { mode = 3; vslot = 10 + wc; }
        else if (pn == 7 || pn == 8) { mode = 3; vslot = 2 + 4 * (pn - 7) + wc; } else if (pn == 2 && wc >= 2) { mode = 3; vslot = wc - 2; }
        if (mode == 0) {
#pragma unroll
            for (int ai = 0; ai < 2; ++ai)
#pragma unroll
                for (int m = 0; m < 4; ++m) { const int row = row0 + ai * HALF + m * 16; bf16_t* rowp = O + (size_t)row * LDC + colh + 8 * fq;
                    const float rs = rstab[ui * 256 + wr * 64 + fr + ai * HALF + m * 16];
#pragma unroll
                    for (int bj = 0; bj < 2; ++bj) { const f32x4 v0 = acc[ai][bj][m][0] * rs, v1 = acc[ai][bj][m][1] * rs;
                        u32x4 w; w.x = cvt_pk_bf16(v0[0], v0[1]); w.y = cvt_pk_bf16(v0[2], v0[3]); w.z = cvt_pk_bf16(v1[0], v1[1]); w.w = cvt_pk_bf16(v1[2], v1[3]);
                        *(u32x4*)(rowp + 32 * bj) = w; }
                    __builtin_amdgcn_sched_barrier(0); }
        } else if (mode == 3) {
#pragma unroll
            for (int ai = 0; ai < 2; ++ai)
#pragma unroll
                for (int m = 0; m < 4; ++m) { const int row = row0 + ai * HALF + m * 16;
                    const float rs = rstab[ui * 256 + wr * 64 + fr + ai * HALF + m * 16];
                    bf16_t* dst = VT + ((size_t)((row >> 13) * 14 + vslot) * 64 + 8 * fq) * SEQL + (row & (SEQL - 1));
#pragma unroll
                    for (int bj = 0; bj < 2; ++bj)
#pragma unroll
                        for (int n = 0; n < 2; ++n) { const f32x4 v = acc[ai][bj][m][n] * rs; const unsigned w0 = cvt_pk_bf16(v[0], v[1]), w1 = cvt_pk_bf16(v[2], v[3]);
                            bf16_t* dp = dst + (size_t)(32 * bj + 4 * n) * SEQL;
                            dp[0] = (bf16_t)(w0 & 0xffffu); dp[SEQL] = (bf16_t)(w0 >> 16); dp[2 * SEQL] = (bf16_t)(w1 & 0xffffu); dp[3 * SEQL] = (bf16_t)(w1 >> 16); }
                    __builtin_amdgcn_sched_barrier(0); }
        } else {
            const float* gp = (mode == 1 ? qgain : kgain) + 8 * fq;
            float g[2][8];
#pragma unroll
            for (int bj = 0; bj < 2; ++bj)
#pragma unroll
                for (int e = 0; e < 8; ++e) g[bj][e] = gp[32 * bj + e];
            const float osc = (mode == 1) ? 0.125f * 1.4426950408889634f : 1.f;
            const float fsc = (fq & 1) ? 0.01f : 1.f;
            const float sgn = (fq < 2) ? -1.f : 1.f;
#pragma unroll
            for (int ai = 0; ai < 2; ++ai)
#pragma unroll
                for (int m = 0; m < 4; ++m) { const int row = row0 + ai * HALF + m * 16; bf16_t* rowp = O + (size_t)row * LDC + colh + 8 * fq;
                    const float rs = rstab[ui * 256 + wr * 64 + fr + ai * HALF + m * 16];
                    float x[2][8]; float q = 0.f;
#pragma unroll
                    for (int bj = 0; bj < 2; ++bj)
#pragma unroll
                        for (int e = 0; e < 8; ++e) { x[bj][e] = acc[ai][bj][m][e >> 2][e & 3] * rs; q += x[bj][e] * x[bj][e]; }
                    q += __shfl_xor(q, 16); q += __shfl_xor(q, 32);
                    const float rr = __builtin_amdgcn_rsqf(q * (1.f / 64.f) + 1e-6f) * osc;
                    int pos = row & (SEQL - 1); asm volatile("" : "+v"(pos));
#pragma unroll
                    for (int bj = 0; bj < 2; ++bj) { const float axv = (float)(bj ? (pos & 63) : (pos >> 6)) * fsc; float o[8];
#pragma unroll
                        for (int e = 0; e < 8; ++e) { const float y = x[bj][e] * rr * g[bj][e]; const float p = __shfl_xor(y, 32);
                            const float fr_ = (e == 0 ? 1.f : e == 1 ? 0.5623413251903491f : e == 2 ? 0.31622776601683794f : e == 3 ? 0.1778279410038923f : e == 4 ? 0.1f : e == 5 ? 0.05623413251903491f : e == 6 ? 0.031622776601683794f : 0.01778279410038923f);
                            const float ang = axv * fr_ * 0.15915494309189535f;
                            const float cs = __builtin_amdgcn_cosf(ang), sn = __builtin_amdgcn_sinf(ang);
                            o[e] = y * cs + sgn * p * sn; }
                        u32x4 w; w.x = cvt_pk_bf16(o[0], o[1]); w.y = cvt_pk_bf16(o[2], o[3]); w.z = cvt_pk_bf16(o[4], o[5]); w.w = cvt_pk_bf16(o[6], o[7]);
                        *(u32x4*)(rowp + 32 * bj) = w; }
                    __builtin_amdgcn_sched_barrier(0); }
        }
    }
};
typedef unsigned u32x2 __attribute__((ext_vector_type(2)));
struct EpiResBf16 {
    static constexpr bool PERM = true, AFTER_DRAIN = false;
    bf16_t* xb; int ldc; unsigned long long* ssq;
    __device__ __forceinline__ void operator()(const f32x4 (&acc)[2][2][4][2], const Unit& u, int wr, int wc, int fr, int fq, int ui) const {
        const int row0 = u.pm * BM + wr * 64 + fr; const int col0 = u.pn * BM + wc * 32 + 8 * fq;
#pragma unroll
        for (int ai = 0; ai < 2; ++ai) {
            u32x4 bs[4][2];
#pragma unroll
            for (int m = 0; m < 4; ++m) { const bf16_t* rowp = xb + (size_t)(row0 + ai * HALF + m * 16) * ldc + col0;
#pragma unroll
                for (int bj = 0; bj < 2; ++bj) bs[m][bj] = *(const u32x4*)(rowp + bj * HALF); }
#pragma unroll
            for (int m = 0; m < 4; ++m) { const int row = row0 + ai * HALF + m * 16; bf16_t* rowp = xb + (size_t)row * ldc + col0;
                float q = 0.f;
#pragma unroll
                for (int bj = 0; bj < 2; ++bj) { u32x4 w;
#pragma unroll
                    for (int p = 0; p < 4; ++p) { const f32x4 a = acc[ai][bj][m][p >> 1]; const unsigned b = bs[m][bj][p];
                        const float lo = __uint_as_float(b << 16) + a[2 * (p & 1)], hi = __uint_as_float(b & 0xffff0000u) + a[2 * (p & 1) + 1];
                        const unsigned pk = cvt_pk_bf16(lo, hi); w[p] = pk;
                        const float rl = __uint_as_float(pk << 16), rh = __uint_as_float(pk & 0xffff0000u); q += rl * rl + rh * rh; }
                    *(u32x4*)(rowp + bj * HALF) = w; }
                q += __shfl_xor(q, 16); q += __shfl_xor(q, 32);
                if (fq == 0) atomicAdd(ssq + row, (unsigned long long)(q * 16777216.f)); }
            asm volatile("" ::: "memory");
        }
    }
};

struct NoHook { static constexpr bool ENABLED = false; __device__ __forceinline__ void operator()(f32x4 (&)[2][2][4][2], int, int, int, int, int) const {} };
struct MixHook { static constexpr bool ENABLED = true; const PG8_LAS float* tab;
    __device__ __forceinline__ void operator()(f32x4 (&acc)[2][2][4][2], int t, int nt, int ui, int wr, int fr) const {
        int sel; if (t == 8) sel = 0; else if (t == 16) sel = 1; else if (t == nt) sel = 2; else return;
        const PG8_LAS float* f = tab + (ui * 3 + sel) * 256 + wr * 64 + fr;
#pragma unroll
        for (int ai = 0; ai < 2; ++ai)
#pragma unroll
            for (int m = 0; m < 4; ++m) { const float sc = f[ai * HALF + m * 16];
#pragma unroll
                for (int bj = 0; bj < 2; ++bj)
#pragma unroll
                    for (int n = 0; n < 2; ++n) acc[ai][bj][m][n] = acc[ai][bj][m][n] * sc; }
    }
};
template <class Epi, class Sched, bool ALIGN_EPI = false, bool SP2 = false, class Hook = NoHook, bool REVK = false>
__device__ __forceinline__ void gemm_phase(PG8_LAS unsigned char* lds, const Gemm g, const Sched& S, const Epi& E, const Hook H = Hook()) {
    int tid_ = threadIdx.x; asm volatile("" : "+v"(tid_));
    const int tid = tid_, wid = __builtin_amdgcn_readfirstlane(tid >> 6), lane = tid & 63, wr = wid >> 2, wc = wid & 3, fr = lane & 15, fq = lane >> 4;
    const int K = g.K, nt = K / BK;
    unsigned voffA[2], voffB[2];
#pragma unroll
    for (int i = 0; i < 2; ++i) { int R, C; stage_rc(tid * 16 + i * 8192, R, C); const int Rb = Epi::PERM ? ((R & ~31) + perm32(R & 31)) : R;
        voffA[i] = (unsigned)(R * K + C) * 2u; voffB[i] = (unsigned)(Rb * K + C) * 2u; }
    const long kstep = REVK ? -(long)(BK * 2) : (long)(BK * 2);
    const size_t krev = REVK ? (size_t)(K / BK - 1) * (size_t)(BK * 2) : 0;
    const size_t hstep = (size_t)HALF * K * 2;
    const size_t tstep = 2 * hstep;
    const unsigned ldsw = (unsigned)wid * 1024u;
    const int aoff = lds_byte(wr * 64 + fr, fq * 8), boff = lds_byte(wc * 32 + fr, fq * 8);
#define PG8_SA(b, h) (((b) * 2 + (h)) * HTB)
#define PG8_SB(b, h) ((4 + (b) * 2 + (h)) * HTB)
#define PG8_STAGE(bufoff, gbase, voff) do { _Pragma("unroll") for (int _i = 0; _i < 2; ++_i) \
        __builtin_amdgcn_global_load_lds((const unsigned*)((const char*)(gbase) + (voff)[_i]), (PG8_LAS unsigned*)(lds + (bufoff) + ldsw + _i * 8192), 16, 0, 0); } while (0)
#define PG8_LDA(dst, b, h) do { _Pragma("unroll") for (int m = 0; m < 4; ++m) _Pragma("unroll") for (int k = 0; k < 2; ++k) dst[m][k] = *(const PG8_LAS bf16x8*)(lds + PG8_SA(b, h) + aoff + m * 2048 + k * 1024); } while (0)
#define PG8_LDB(dst, b, h) do { _Pragma("unroll") for (int n = 0; n < 2; ++n) _Pragma("unroll") for (int k = 0; k < 2; ++k) dst[n][k] = *(const PG8_LAS bf16x8*)(lds + PG8_SB(b, h) + boff + n * 2048 + k * 1024); } while (0)
#define PG8_MMA(ai, bj, At, Bt) do { __builtin_amdgcn_s_setprio(1); _Pragma("unroll") for (int m = 0; m < 4; ++m) _Pragma("unroll") for (int n = 0; n < 2; ++n) _Pragma("unroll") for (int k = 0; k < 2; ++k) \
        acc[ai][bj][m][n] = __builtin_amdgcn_mfma_f32_16x16x32_bf16(Bt[n][k], At[m][k], acc[ai][bj][m][n], 0, 0, 0); __builtin_amdgcn_s_setprio(0); } while (0)
#define PG8_WAIT_V(n) asm volatile("s_waitcnt vmcnt(" #n ")" ::: "memory")
#define PG8_WAIT_L(n) asm volatile("s_waitcnt lgkmcnt(" #n ")" ::: "memory")
#define PG8_BAR __builtin_amdgcn_s_barrier()
#define PG8_SCHED __builtin_amdgcn_sched_barrier(0)
    Unit cur, nxt; int ui = 0;
    if (!S.next(0, cur)) return;
    f32x4 acc[2][2][4][2];
#pragma unroll
    for (int a = 0; a < 2; ++a)
#pragma unroll
        for (int b = 0; b < 2; ++b)
#pragma unroll
            for (int m = 0; m < 4; ++m)
#pragma unroll
                for (int n = 0; n < 2; ++n) acc[a][b][m][n] = (f32x4){0.f, 0.f, 0.f, 0.f};
    bf16x8 At[4][2], B0[2][2], B1[2][2];
    const char* cA = (const char*)g.A + (size_t)cur.pm * tstep + krev; const char* cB = (const char*)g.Bt + (size_t)cur.pn * tstep + krev;
    S.a_ready(cur);
    if constexpr (SP2) {
        PG8_STAGE(PG8_SB(0, 0), cB, voffB); PG8_STAGE(PG8_SB(0, 1), cB + hstep, voffB); PG8_STAGE(PG8_SA(0, 0), cA, voffA); PG8_STAGE(PG8_SA(0, 1), cA + hstep, voffA);
        if (wr == 1) PG8_BAR;
        PG8_WAIT_V(2); PG8_BAR;
        PG8_STAGE(PG8_SB(1, 0), cB + kstep, voffB); PG8_STAGE(PG8_SA(1, 0), cA + kstep, voffA); PG8_STAGE(PG8_SB(1, 1), cB + hstep + kstep, voffB);
        PG8_WAIT_V(6); PG8_BAR;
    } else {
        PG8_STAGE(PG8_SB(0, 0), cB, voffB); PG8_STAGE(PG8_SA(0, 0), cA, voffA); PG8_STAGE(PG8_SB(0, 1), cB + hstep, voffB); PG8_STAGE(PG8_SA(0, 1), cA + hstep, voffA);
        if (wr == 1) PG8_BAR;
        PG8_WAIT_V(4); PG8_BAR;
        PG8_STAGE(PG8_SB(1, 0), cB + kstep, voffB); PG8_STAGE(PG8_SA(1, 0), cA + kstep, voffA); PG8_STAGE(PG8_SB(1, 1), cB + hstep + kstep, voffB);
        PG8_WAIT_V(6); PG8_BAR;
    }
    for (;;) {
        const bool has_next = S.next(ui + 1, nxt);
        const char* nA = has_next ? (const char*)g.A + (size_t)nxt.pm * tstep + krev : cA; const char* nB = has_next ? (const char*)g.Bt + (size_t)nxt.pn * tstep + krev : cB;
        for (int t = 0; t < nt; t += 2) {
            if constexpr (Hook::ENABLED) H(acc, t, nt, ui, wr, fr);
            const bool last = (t == nt - 2);
            const char* a1 = cA + (long)(t + 1) * kstep;
            const char* a2 = last ? nA : cA + (long)(t + 2) * kstep; const char* b2 = last ? nB : cB + (long)(t + 2) * kstep;
            const char* a3 = a2 + kstep; const char* b3 = b2 + kstep;
            if (last && has_next) S.a_ready(nxt);
            if constexpr (SP2) {
            PG8_LDB(B0, 0, 0); PG8_LDB(B1, 0, 1); PG8_SCHED; PG8_LDA(At, 0, 0); PG8_STAGE(PG8_SA(1, 1), a1 + hstep, voffA);
            PG8_WAIT_V(8); PG8_WAIT_L(0); PG8_BAR; PG8_MMA(0, 0, At, B0); PG8_MMA(0, 1, At, B1); PG8_BAR; PG8_SCHED;
            PG8_LDA(At, 0, 1); PG8_STAGE(PG8_SB(0, 0), b2, voffB); PG8_STAGE(PG8_SB(0, 1), b2 + hstep, voffB); PG8_STAGE(PG8_SA(0, 0), a2, voffA);
            PG8_WAIT_V(8); PG8_WAIT_L(0); PG8_BAR; PG8_MMA(1, 0, At, B0); PG8_MMA(1, 1, At, B1); PG8_BAR; PG8_SCHED;
            PG8_LDB(B0, 1, 0); PG8_LDB(B1, 1, 1); PG8_SCHED; PG8_LDA(At, 1, 0); PG8_STAGE(PG8_SA(0, 1), a2 + hstep, voffA);
            PG8_WAIT_V(8); PG8_WAIT_L(0); PG8_BAR; PG8_MMA(0, 0, At, B0); PG8_MMA(0, 1, At, B1); PG8_BAR; PG8_SCHED;
            PG8_LDA(At, 1, 1); PG8_STAGE(PG8_SB(1, 0), b3, voffB); PG8_STAGE(PG8_SB(1, 1), b3 + hstep, voffB); PG8_STAGE(PG8_SA(1, 0), a3, voffA);
            PG8_WAIT_V(8); PG8_WAIT_L(0); PG8_BAR; PG8_MMA(1, 0, At, B0); PG8_MMA(1, 1, At, B1); PG8_BAR; PG8_SCHED;
            } else {
            PG8_LDB(B0, 0, 0); PG8_SCHED; PG8_LDA(At, 0, 0); PG8_STAGE(PG8_SA(1, 1), a1 + hstep, voffA);
            PG8_WAIT_L(8); PG8_BAR; PG8_WAIT_L(0); PG8_MMA(0, 0, At, B0); PG8_BAR; PG8_SCHED;
            PG8_LDB(B1, 0, 1); PG8_STAGE(PG8_SB(0, 0), b2, voffB);
            PG8_BAR; PG8_WAIT_L(0); PG8_MMA(0, 1, At, B1); PG8_BAR;
            PG8_LDA(At, 0, 1); PG8_STAGE(PG8_SA(0, 0), a2, voffA);
            PG8_BAR; PG8_WAIT_L(0); PG8_MMA(1, 0, At, B0); PG8_BAR; PG8_SCHED;
            PG8_STAGE(PG8_SB(0, 1), b2 + hstep, voffB);
            PG8_WAIT_V(6); PG8_BAR; PG8_MMA(1, 1, At, B1); PG8_BAR;
            PG8_LDB(B0, 1, 0); PG8_SCHED; PG8_LDA(At, 1, 0); PG8_STAGE(PG8_SA(0, 1), a2 + hstep, voffA);
            PG8_WAIT_L(8); PG8_BAR; PG8_WAIT_L(0); PG8_MMA(0, 0, At, B0); PG8_BAR; PG8_SCHED;
            PG8_LDB(B1, 1, 1); PG8_STAGE(PG8_SB(1, 0), b3, voffB);
            PG8_BAR; PG8_WAIT_L(0); PG8_MMA(0, 1, At, B1); PG8_BAR;
            PG8_LDA(At, 1, 1); PG8_STAGE(PG8_SA(1, 0), a3, voffA);
            PG8_BAR; PG8_WAIT_L(0); PG8_MMA(1, 0, At, B0); PG8_BAR; PG8_SCHED;
            PG8_STAGE(PG8_SB(1, 1), b3 + hstep, voffB);
            PG8_WAIT_V(6); PG8_BAR; PG8_MMA(1, 1, At, B1); PG8_BAR;
            }
        }
        if constexpr (Hook::ENABLED) H(acc, nt, nt, ui, wr, fr);
        if constexpr (ALIGN_EPI) { if (wr == 0) PG8_BAR; }
        if constexpr (!Epi::AFTER_DRAIN) { E(acc, cur, wr, wc, fr, fq, ui); S.done(cur); }
        if (!has_next) break;
#pragma unroll
        for (int a = 0; a < 2; ++a)
#pragma unroll
            for (int b = 0; b < 2; ++b)
#pragma unroll
                for (int m = 0; m < 4; ++m)
#pragma unroll
                    for (int n = 0; n < 2; ++n) acc[a][b][m][n] = (f32x4){0.f, 0.f, 0.f, 0.f};
        cur = nxt; cA = nA; cB = nB; ++ui;
        if constexpr (ALIGN_EPI) { if (wr == 1) PG8_BAR; }
    }
    PG8_WAIT_V(0);
    if constexpr (!ALIGN_EPI) { if (wr == 0) PG8_BAR; }
    PG8_BAR;
    if constexpr (Epi::AFTER_DRAIN) { E.fused(acc, cur, wr, wc, fr, fq, lds, wid, lane); S.done(cur); }
#undef PG8_SA
#undef PG8_SB
#undef PG8_STAGE
#undef PG8_LDA
#undef PG8_LDB
#undef PG8_MMA
#undef PG8_WAIT_V
#undef PG8_WAIT_L
#undef PG8_BAR
#undef PG8_SCHED
}
}

typedef unsigned short bf16_t;
#define LAS __attribute__((address_space(3)))
typedef short bf16x8 __attribute__((ext_vector_type(8)));
typedef float f32x4 __attribute__((ext_vector_type(4)));
typedef float f32x16 __attribute__((ext_vector_type(16)));
typedef unsigned u32x4 __attribute__((ext_vector_type(4)));
typedef unsigned u32x2 __attribute__((ext_vector_type(2)));

constexpr int BATCH = 2, SEQ = 8192, DM = 2048, DEPTH = 4, MTOK = BATCH * SEQ, INW = 3840, DFF = 8192;
constexpr int QA_OFF = 0, KA_OFF = 512, VA_OFF = 640, QB_OFF = 768, KB_OFF = 1280, VB_OFF = 1792, QC_OFF = 2304, KC_OFF = 3328, VC_OFF = 3584;
constexpr int NVS = 14;
constexpr float LOG2E = 1.4426950408889634f;
constexpr float C2 = 0.125f * 1.4426950408889634f;
constexpr float EPS = 1e-6f;
constexpr float NEGBIG = -1e30f;

constexpr size_t SZ_WIN = (size_t)INW * DM * 2, SZ_WO = (size_t)DM * DM * 2, SZ_WUP = (size_t)DFF * DM * 2, SZ_WDN = (size_t)DM * DFF * 2;
constexpr size_t WS_WIN = 0;
constexpr size_t WS_WO = WS_WIN + DEPTH * SZ_WIN;
constexpr size_t WS_WUP = WS_WO + DEPTH * SZ_WO;
constexpr size_t WS_WDN = WS_WUP + DEPTH * SZ_WUP;
constexpr size_t WS_H = WS_WDN + DEPTH * SZ_WDN;
constexpr size_t WS_PROJ = WS_H + (size_t)MTOK * DM * 2;
constexpr size_t WS_VT = WS_PROJ + (size_t)MTOK * INW * 2;
constexpr size_t WS_O = WS_VT + (size_t)BATCH * NVS * 64 * SEQ * 2;
constexpr size_t WS_MIX = WS_O + (size_t)MTOK * DM * 2;
constexpr size_t WS_MIXEND = WS_MIX + (size_t)MTOK * DM * 2;
constexpr size_t WS_SS = WS_MIXEND;
constexpr size_t WS_SG = WS_SS + (size_t)(2 * DEPTH + 1) * MTOK * 8;
constexpr size_t WS_BAR = WS_SG + (size_t)DEPTH * 3 * MTOK * 8;
constexpr size_t WS_END = WS_BAR + 16384;
constexpr size_t WS_U = WS_PROJ;
static_assert(WS_U + (size_t)MTOK * DFF * 2 <= WS_MIXEND, "U overlay");
constexpr int LDS_BYTES = 147456;

struct Params {
    const float *x, *norm_mix, *w_in, *a_sink, *t5, *b_rpb, *c_q_gain, *c_k_gain, *og_a, *og_b, *og_c, *w_o, *norm_mlp, *w_up, *w_down, *norm_final;
    float* out; unsigned char* ws;
};
typedef const __attribute__((address_space(4))) Params* CP;
#define PP() ({ CP q_ = (CP)__builtin_amdgcn_kernarg_segment_ptr(); asm volatile("" : "+s"(q_)); q_; })

__device__ __forceinline__ float wave_sum(float v) {
#pragma unroll
    for (int o = 1; o < 64; o <<= 1) v += __shfl_xor(v, o);
    return v;
}
__device__ __forceinline__ unsigned pk_bf16(float lo, float hi) { return pg8::cvt_pk_bf16(lo, hi); }
__device__ __forceinline__ float bf_lo(unsigned w) { return __uint_as_float(w << 16); }
__device__ __forceinline__ float bf_hi(unsigned w) { return __uint_as_float(w & 0xffff0000u); }

constexpr int WI_IN = (DM / 64) * (INW / 32), WI_O = (DM / 64) * (DM / 32), WI_UP = (DM / 64) * (DFF / 32), WI_DN = (DFF / 64) * (DM / 32);
constexpr int W_PER_L = WI_IN + WI_O + WI_UP + WI_DN;
constexpr int W_DEFER = 6144;
struct WItem { const float* src; bf16_t* dst; const float* kg; int N, K; };
__device__ __forceinline__ void witem_desc(CP P, int l, int r, int lane, WItem& d) {
    unsigned char* ws = P->ws;
    const float* W; bf16_t* WT; const float* kgain; int K, N; bool permute = false;
    if (r < WI_IN) { W = P->w_in + (size_t)l * DM * INW; K = DM; N = INW; WT = (bf16_t*)(ws + WS_WIN + l * SZ_WIN); kgain = P->norm_mix + l * DM; permute = true; }
    else if ((r -= WI_IN) < WI_O) { W = P->w_o + (size_t)l * DM * DM; K = DM; N = DM; WT = (bf16_t*)(ws + WS_WO + l * SZ_WO);
        const int kk = 64 * (r / (DM / 32));
        kgain = kk < 512 ? P->og_a + l * 512 : kk < 1024 ? P->og_b + l * 512 - 512 : P->og_c + l * 1024 - 1024; }
    else if ((r -= WI_O) < WI_UP) { W = P->w_up + (size_t)l * DM * DFF; K = DM; N = DFF; WT = (bf16_t*)(ws + WS_WUP + l * SZ_WUP); kgain = P->norm_mlp + l * DM; }
    else { r -= WI_UP; W = P->w_down + (size_t)l * DFF * DM; K = DFF; N = DM; WT = (bf16_t*)(ws + WS_WDN + l * SZ_WDN); kgain = nullptr; }
    const int nblk = N / 32, kb = r / nblk, nb = r % nblk, k0 = 64 * kb, n0 = 32 * nb;
    const int d0 = permute ? (n0 & ~255) + 32 * (4 * (nb & 1) + ((nb & 7) >> 1)) : n0;
    const int g = lane & 7, nq = lane >> 3;
    d.src = W + (size_t)(k0 + 8 * g) * N + n0 + 4 * nq; d.dst = WT + (size_t)(d0 + 4 * nq) * K + k0 + 8 * g; d.kg = kgain ? kgain + k0 + 8 * g : nullptr; d.N = N; d.K = K;
}
__device__ __forceinline__ void witem_load(const WItem& d, f32x4 (&v)[8]) {
#pragma unroll
    for (int t = 0; t < 8; ++t) v[t] = __builtin_nontemporal_load((const f32x4*)(d.src + (size_t)t * d.N));
}
__device__ __forceinline__ void witem_finish(const WItem& d, f32x4 (&v)[8]) {
    if (d.kg) { const f32x4 g0 = *(const f32x4*)(d.kg), g1 = *(const f32x4*)(d.kg + 4);
#pragma unroll
        for (int t = 0; t < 4; ++t) { v[t] = v[t] * g0[t]; v[4 + t] = v[4 + t] * g1[t]; } }
#pragma unroll
    for (int j = 0; j < 4; ++j) { u32x4 o; o.x = pk_bf16(v[0][j], v[1][j]); o.y = pk_bf16(v[2][j], v[3][j]); o.z = pk_bf16(v[4][j], v[5][j]); o.w = pk_bf16(v[6][j], v[7][j]);
        __builtin_nontemporal_store(o, (u32x4*)(d.dst + (size_t)j * d.K)); }
}
template <class IDX>
__device__ __forceinline__ void weights_run(CP P, int total, int widx, int nw, int lane, const IDX& idx) {
    for (int it = widx; it < total; it += 2 * nw) {
        const bool two = it + nw < total;
        int la, ra, lb, rb; idx(it, la, ra); idx(two ? it + nw : it, lb, rb);
        WItem A, B; witem_desc(P, la, ra, lane, A); witem_desc(P, lb, rb, lane, B);
        f32x4 va[8], vb[8];
        witem_load(A, va); if (two) witem_load(B, vb);
        witem_finish(A, va); if (two) witem_finish(B, vb);
    }
}
constexpr int W_ATT_OWN = W_PER_L - WI_IN - W_DEFER;
static_assert(W_ATT_OWN + WI_IN <= 1024 * 16, "1024 A/B units x 8 waves x 2 items cover the attention-deferred list");
__device__ __forceinline__ bool witem_att(int layer, int i, int& l, int& r) {
    if (i < W_ATT_OWN) { l = layer; r = WI_IN + W_DEFER + i; return true; }
    if (layer + 1 < DEPTH && i < W_ATT_OWN + WI_IN) { l = layer + 1; r = i - W_ATT_OWN; return true; }
    return false;
}
__device__ __forceinline__ void weights_phase(CP P, LAS unsigned char* lds) {
    int tid_ = threadIdx.x; asm volatile("" : "+v"(tid_));
    const int lane = tid_ & 63, wave = __builtin_amdgcn_readfirstlane(tid_ >> 6);
    weights_run(P, WI_IN, blockIdx.x * 8 + wave, gridDim.x * 8, lane, [](int i, int& l, int& r) { l = 0; r = i; });
}
__device__ __forceinline__ void weights_deferred(CP P, int layer) {
    const int G = gridDim.x, c = blockIdx.x, rem = ((MTOK / 256) * (INW / 256)) % G;
    if (rem != 0 && c < rem) return;
    int tid_ = threadIdx.x; asm volatile("" : "+v"(tid_));
    const int lane = tid_ & 63, wave = __builtin_amdgcn_readfirstlane(tid_ >> 6);
    const int rank = rem ? c - rem : c, cnt = rem ? G - rem : G;
    weights_run(P, W_DEFER, rank * 8 + wave, cnt * 8, lane, [layer](int i, int& l, int& r) { l = layer; r = WI_IN + i; });
}

__device__ __forceinline__ void xinit_phase(const float* xin, bf16_t* xb, unsigned long long* ss) {
    int tid_ = threadIdx.x; asm volatile("" : "+v"(tid_));
    const int lane = tid_ & 63, wave = __builtin_amdgcn_readfirstlane(tid_ >> 6);
    const int gw = blockIdx.x * 8 + wave, NGW = gridDim.x * 8;
    for (int i = blockIdx.x * 512 + tid_; i < (2 * DEPTH + 3 * DEPTH) * MTOK; i += gridDim.x * 512) ss[MTOK + i] = 0ull;
    for (int row = gw; row < MTOK; row += NGW) {
        const f32x4* xr = (const f32x4*)(xin + (size_t)row * DM) + lane;
        u32x2* o = (u32x2*)(xb + (size_t)row * DM) + lane;
        float s = 0.f;
#pragma unroll
        for (int j = 0; j < 8; ++j) { const f32x4 v = xr[64 * j]; u32x2 w; w.x = pk_bf16(v.x, v.y); w.y = pk_bf16(v.z, v.w); o[64 * j] = w;
            const float a = bf_lo(w.x), b = bf_hi(w.x), c = bf_lo(w.y), d = bf_hi(w.y); s += (a * a + b * b) + (c * c + d * d); }
        s = wave_sum(s);
        if (lane == 0) ss[row] = (unsigned long long)(s * 16777216.f);
    }
}
__device__ __forceinline__ void final_phase(const bf16_t* xb, float* out, const float* gain, const unsigned long long* ss) {
    int tid_ = threadIdx.x; asm volatile("" : "+v"(tid_));
    const int lane = tid_ & 63, wave = __builtin_amdgcn_readfirstlane(tid_ >> 6);
    const int gw = blockIdx.x * 8 + wave, NGW = gridDim.x * 8;
    for (int row = gw; row < MTOK; row += NGW) {
        const u32x2* xr = (const u32x2*)(xb + (size_t)row * DM) + lane;
        f32x4* o = (f32x4*)(out + (size_t)row * DM) + lane;
        const float r = rsqrtf((float)ss[row] * (1.f / (DM * 16777216.f)) + EPS);
#pragma unroll
        for (int j = 0; j < 8; ++j) { const u32x2 w = xr[64 * j]; const f32x4 g = ((const f32x4*)gain)[lane + 64 * j];
            f32x4 v; v.x = bf_lo(w.x) * r * g.x; v.y = bf_hi(w.x) * r * g.y; v.z = bf_lo(w.y) * r * g.z; v.w = bf_hi(w.y) * r * g.w; o[64 * j] = v; }
    }
}

__device__ __forceinline__ constexpr float rope_freq(int i) {
    return i == 0 ? 1.f : i == 1 ? 0.5623413251903491f : i == 2 ? 0.31622776601683794f : i == 3 ? 0.1778279410038923f :
           i == 4 ? 0.1f : i == 5 ? 0.05623413251903491f : i == 6 ? 0.031622776601683794f : i == 7 ? 0.01778279410038923f :
           i == 8 ? 0.01f : i == 9 ? 0.005623413251903491f : i == 10 ? 0.0031622776601683794f : i == 11 ? 0.001778279410038923f :
           i == 12 ? 0.001f : i == 13 ? 0.0005623413251903491f : i == 14 ? 0.00031622776601683794f : 0.0001778279410038923f;
}
__device__ __forceinline__ void prep_phase(CP P, int layer) {
    int tid_ = threadIdx.x; asm volatile("" : "+v"(tid_));
    const int lane = tid_ & 63, wave = __builtin_amdgcn_readfirstlane(tid_ >> 6);
    const int gw = blockIdx.x * 8 + wave, NGW = gridDim.x * 8;
    bf16_t* proj = (bf16_t*)(P->ws + WS_PROJ); bf16_t* vt = (bf16_t*)(P->ws + WS_VT);
    for (int it = gw; it < 34 * (MTOK / 64); it += NGW) {
        const int slot = it % 34, tb = it / 34;
        const int tok = tb * 64 + lane, pos = tok & (SEQ - 1), b = tok >> 13;
        int col;
        if (slot < 16) col = QC_OFF + 64 * slot; else if (slot < 20) col = KC_OFF + 64 * (slot - 16);
        else if (slot < 22) col = VA_OFF + 64 * (slot - 20); else if (slot < 30) col = VB_OFF + 64 * (slot - 22); else col = VC_OFF + 64 * (slot - 30);
        u32x4* p = (u32x4*)(proj + (size_t)tok * INW + col);
        u32x4 raw[8];
#pragma unroll
        for (int j = 0; j < 8; ++j) raw[j] = p[j];
        if (slot < 20) {
            const float* gn = (slot < 16 ? P->c_q_gain : P->c_k_gain) + layer * 64;
            asm volatile("" : "+s"(gn));
            float ss = 0.f;
#pragma unroll
            for (int j = 0; j < 8; ++j)
#pragma unroll
                for (int q = 0; q < 4; ++q) { const float a = bf_lo(raw[j][q]), c = bf_hi(raw[j][q]); ss += a * a + c * c; }
            const float rr = rsqrtf(ss * (1.f / 64.f) + EPS) * ((slot < 16) ? C2 : 1.f);
            const float rowf = (float)(pos >> 6), colf = (float)(pos & 63);
            u32x4 outw[8];
#pragma unroll
            for (int i = 0; i < 16; i += 2) {
                const unsigned wa = raw[i >> 3][(i & 7) >> 1], wb = raw[(16 + i) >> 3][(i & 7) >> 1], wc = raw[(32 + i) >> 3][(i & 7) >> 1], wd = raw[(48 + i) >> 3][(i & 7) >> 1];
                float r1[2], r2[2], r3[2], r4[2];
#pragma unroll
                for (int e = 0; e < 2; ++e) {
                    const int d = i + e; const float f = rope_freq(d);
                    const float x1 = (e ? bf_hi(wa) : bf_lo(wa)) * rr * gn[d], x2 = (e ? bf_hi(wb) : bf_lo(wb)) * rr * gn[16 + d];
                    const float y1 = (e ? bf_hi(wc) : bf_lo(wc)) * rr * gn[32 + d], y2 = (e ? bf_hi(wd) : bf_lo(wd)) * rr * gn[48 + d];
                    const float ar = rowf * f, ac = colf * f;
                    const float cr = __cosf(ar), sr = __sinf(ar), cc = __cosf(ac), sc = __sinf(ac);
                    r1[e] = x1 * cr - x2 * sr; r2[e] = x2 * cr + x1 * sr; r3[e] = y1 * cc - y2 * sc; r4[e] = y2 * cc + y1 * sc;
                }
                outw[i >> 3][(i & 7) >> 1] = pk_bf16(r1[0], r1[1]); outw[(16 + i) >> 3][(i & 7) >> 1] = pk_bf16(r2[0], r2[1]);
                outw[(32 + i) >> 3][(i & 7) >> 1] = pk_bf16(r3[0], r3[1]); outw[(48 + i) >> 3][(i & 7) >> 1] = pk_bf16(r4[0], r4[1]);
                __builtin_amdgcn_sched_barrier(0);
            }
#pragma unroll
            for (int j = 0; j < 8; ++j) p[j] = outw[j];
        } else {
            const int vs = slot - 20;
            bf16_t* dst = vt + ((size_t)(b * NVS + vs) * 64) * SEQ + pos;
#pragma unroll
            for (int j = 0; j < 8; ++j)
#pragma unroll
                for (int q = 0; q < 4; ++q) { const unsigned w = raw[j][q]; dst[(size_t)(8 * j + 2 * q) * SEQ] = (bf16_t)(w & 0xffffu); dst[(size_t)(8 * j + 2 * q + 1) * SEQ] = (bf16_t)(w >> 16); }
        }
    }
}

constexpr int KP = 144;
constexpr int ATT_TILE = 64 * KP;
constexpr int ATT_K = 0, ATT_V = 2 * ATT_TILE, ATT_BIAS = 4 * ATT_TILE;
__device__ __forceinline__ float sq2(unsigned w) { const float a = bf_lo(w), b = bf_hi(w); return a * a + b * b; }
__device__ __forceinline__ int t5_bucket(int rel) {
    const int base = rel > 0 ? 16 : 0; const int n = rel < 0 ? -rel : rel; int v;
    if (n < 8) v = n; else if (n < 12) v = 8; else if (n < 16) v = 9; else if (n < 23) v = 10; else if (n < 32) v = 11;
    else if (n < 46) v = 12; else if (n < 64) v = 13; else if (n < 91) v = 14; else v = 15;
    return base + v;
}
__device__ __forceinline__ int clampi(int v, int lo, int hi) { return v < lo ? lo : (v > hi ? hi : v); }

template <int MODE>
__device__ __forceinline__ void attn_unit(LAS unsigned char* lds, const bf16_t* proj, const bf16_t* vt, bf16_t* obuf,
                                          int b, int hk, int blk, const float* btab, const float* sink, unsigned long long* sg, bool build_lut, CP WP, int wlayer, int wbase) {
    int tid_ = threadIdx.x; asm volatile("" : "+v"(tid_));
    const int tid = tid_, lane = tid & 63, r = lane & 31, h = lane >> 5;
    const int w = __builtin_amdgcn_readfirstlane(tid >> 6);
    WItem wiA, wiB; f32x4 wva[8], wvb[8]; bool whA = false, whB = false;
    if (MODE != 2 && wlayer >= 0) { int l_, r_;
        whA = witem_att(wlayer, wbase + 2 * w, l_, r_); if (whA) { witem_desc(WP, l_, r_, lane, wiA); witem_load(wiA, wva); }
        whB = witem_att(wlayer, wbase + 2 * w + 1, l_, r_); if (whB) { witem_desc(WP, l_, r_, lane, wiB); witem_load(wiB, wvb); } }
    int qhead, qpos, qcol, kcol, vslot, ocol, T0, T1, w0 = 0, w1 = 0, grow = 0;
    if (MODE == 0)      { qhead = 4 * hk + (w >> 1); qpos = blk * 64 + 32 * (w & 1) + r; qcol = QA_OFF + 64 * qhead; kcol = KA_OFF + 64 * hk; vslot = hk; ocol = 64 * qhead;
                          T0 = blk - 2 < 0 ? 0 : blk - 2; T1 = blk + 2 > 127 ? 127 : blk + 2; }
    else if (MODE == 2) { qhead = 4 * hk + (w >> 1); qpos = blk * 64 + 32 * (w & 1) + r; qcol = QC_OFF + 64 * qhead; kcol = KC_OFF + 64 * hk; vslot = 10 + hk; ocol = 1024 + 64 * qhead;
                          T0 = 0; T1 = 127; }
    else                { qhead = hk; qpos = blk * 256 + 32 * w + r; qcol = QB_OFF + 64 * hk; kcol = KB_OFF + 64 * hk; vslot = 2 + hk; ocol = 512 + 64 * hk;
                          grow = 4 * blk + (w >> 1); T0 = clampi(4 * blk - 4, 0, 120); T1 = clampi(4 * blk - 1, 0, 120) + 7; w0 = clampi(grow - 4, 0, 120); w1 = w0 + 7; }
    LAS float* bias = (LAS float*)(lds + ATT_BIAS);
    float pen0[16], pen1[16];
    if (MODE == 0 && build_lut) {
        for (int idx = tid; idx < 4 * 384; idx += 512) { const int hh = idx / 384, rel = idx % 384 - 192;
            bias[idx] = (rel >= -128 && rel <= 128) ? btab[t5_bucket(rel) * 8 + 4 * hk + hh] * LOG2E : NEGBIG; }
    } else if (MODE == 1) {
        for (int idx = tid; idx < 15 * 128; idx += 512) { const int dr = idx >> 7, y = idx & 127; bias[idx] = btab[(hk * 15 + dr) * 31 + clampi(y - 48, 0, 30)] * LOG2E; }
        const int c = 32 * (w & 1) + r, cs = clampi(c - 8, 0, 48);
#pragma unroll
        for (int i = 0; i < 16; ++i) { const int k0 = 16 * (i >> 3) + 8 * h + (i & 7), k1 = k0 + 32;
            pen0[i] = (k0 >= cs && k0 < cs + 16) ? 0.f : NEGBIG; pen1[i] = (k1 >= cs && k1 < cs + 16) ? 0.f : NEGBIG; }
    }
    const size_t tokbase = (size_t)b * SEQ;
    const int srow = tid >> 3, sch = tid & 7;
    const bf16_t* kg = proj + (tokbase + srow) * INW + kcol + sch * 8;
    const bf16_t* vg = vt + ((size_t)(b * NVS + vslot) * 64 + srow) * SEQ + sch * 8;
    const unsigned sdst = srow * KP + sch * 16;
    u32x4 kreg, vreg;
    const bf16_t* qg = proj + (tokbase + qpos) * INW + qcol + 8 * h;
    bf16x8 qf[4];
#pragma unroll
    for (int ks = 0; ks < 4; ++ks) qf[ks] = *(const bf16x8*)(qg + 16 * ks);
    float m = (MODE == 0) ? sink[qhead] * LOG2E : NEGBIG;
    float l = (MODE == 0 && h == 0) ? 1.f : 0.f;
    f32x16 o0, o1;
#pragma unroll
    for (int i = 0; i < 16; ++i) { o0[i] = 0.f; o1[i] = 0.f; }
    const int pr = (r & ~12) | ((r & 4) << 1) | ((r & 8) >> 1);
    const int nT = T1 - T0 + 1;
    kreg = *(const u32x4*)(kg + (size_t)(T0 * 64) * INW); vreg = *(const u32x4*)(vg + T0 * 64);
    *(LAS u32x4*)(lds + ATT_K + sdst) = kreg; *(LAS u32x4*)(lds + ATT_V + sdst) = vreg;
    __syncthreads();
    for (int it = 0; it < nT; ++it) {
        const int T = T0 + it, buf = it & 1;
        if (it + 1 < nT) { kreg = *(const u32x4*)(kg + (size_t)((T + 1) * 64) * INW); vreg = *(const u32x4*)(vg + (T + 1) * 64); }
        const bool active = (MODE != 1) || (T >= w0 && T <= w1);
        if (active) {
            const LAS unsigned char* kb = lds + ATT_K + buf * ATT_TILE + pr * KP + 16 * h;
            f32x16 s0, s1;
#pragma unroll
            for (int i = 0; i < 16; ++i) { s0[i] = 0.f; s1[i] = 0.f; }
#pragma unroll
            for (int ks = 0; ks < 4; ++ks) {
                const bf16x8 a0 = *(const LAS bf16x8*)(kb + 32 * ks);
                const bf16x8 a1 = *(const LAS bf16x8*)(kb + 32 * KP + 32 * ks);
                s0 = __builtin_amdgcn_mfma_f32_32x32x16_bf16(a0, qf[ks], s0, 0, 0, 0);
                s1 = __builtin_amdgcn_mfma_f32_32x32x16_bf16(a1, qf[ks], s1, 0, 0, 0);
            }
            if (MODE == 0) {
                const LAS float* bh = bias + (w >> 1) * 384 + (T * 64 - qpos + 192 + 8 * h);
#pragma unroll
                for (int i = 0; i < 16; ++i) { const int o_ = 16 * (i >> 3) + (i & 7);
                    s0[i] = s0[i] * C2 + bh[o_]; s1[i] = s1[i] * C2 + bh[o_ + 32]; }
            } else if (MODE == 1) {
                const LAS float* bh = bias + (T - grow + 7) * 128 + (63 - (32 * (w & 1) + r) + 8 * h);
#pragma unroll
                for (int i = 0; i < 16; ++i) { const int o_ = 16 * (i >> 3) + (i & 7);
                    s0[i] = (s0[i] * C2 + bh[o_]) + pen0[i]; s1[i] = (s1[i] * C2 + bh[o_ + 32]) + pen1[i]; }
            }
            float mx = fmaxf(s0[0], s1[0]);
#pragma unroll
            for (int i = 1; i < 16; ++i) mx = fmaxf(mx, fmaxf(s0[i], s1[i]));
            mx = fmaxf(mx, __shfl_xor(mx, 32));
            const float mnew = fmaxf(m, mx);
            const float alpha = __builtin_amdgcn_exp2f(m - mnew);
            m = mnew;
            float ps = 0.f;
#pragma unroll
            for (int i = 0; i < 16; ++i) { s0[i] = __builtin_amdgcn_exp2f(s0[i] - mnew); s1[i] = __builtin_amdgcn_exp2f(s1[i] - mnew); ps += s0[i] + s1[i]; }
            l = l * alpha + ps;
#pragma unroll
            for (int i = 0; i < 16; ++i) { o0[i] *= alpha; o1[i] *= alpha; }
            u32x4 pw[4];
#pragma unroll
            for (int q = 0; q < 4; ++q) { pw[0][q] = pk_bf16(s0[2 * q], s0[2 * q + 1]); pw[1][q] = pk_bf16(s0[8 + 2 * q], s0[8 + 2 * q + 1]);
                                          pw[2][q] = pk_bf16(s1[2 * q], s1[2 * q + 1]); pw[3][q] = pk_bf16(s1[8 + 2 * q], s1[8 + 2 * q + 1]); }
            const LAS unsigned char* vb = lds + ATT_V + buf * ATT_TILE + r * KP + 16 * h;
#pragma unroll
            for (int ks = 0; ks < 4; ++ks) {
                const bf16x8 a0 = *(const LAS bf16x8*)(vb + 32 * ks);
                const bf16x8 a1 = *(const LAS bf16x8*)(vb + 32 * KP + 32 * ks);
                const bf16x8 pf = __builtin_bit_cast(bf16x8, pw[ks]);
                o0 = __builtin_amdgcn_mfma_f32_32x32x16_bf16(a0, pf, o0, 0, 0, 0);
                o1 = __builtin_amdgcn_mfma_f32_32x32x16_bf16(a1, pf, o1, 0, 0, 0);
            }
        }
        if (it + 1 < nT) { *(LAS u32x4*)(lds + ATT_K + (buf ^ 1) * ATT_TILE + sdst) = kreg; *(LAS u32x4*)(lds + ATT_V + (buf ^ 1) * ATT_TILE + sdst) = vreg; }
        __syncthreads();
    }
    if (MODE != 2) { if (whA) witem_finish(wiA, wva); if (whB) witem_finish(wiB, wvb); }
    l += __shfl_xor(l, 32);
    const float inv = 1.f / l;
    bf16_t* og = obuf + (tokbase + qpos) * DM + ocol + 4 * h;
    float qs = 0.f;
#pragma unroll
    for (int g = 0; g < 4; ++g) {
        u32x2 a, c;
        a.x = pk_bf16(o0[4 * g] * inv, o0[4 * g + 1] * inv); a.y = pk_bf16(o0[4 * g + 2] * inv, o0[4 * g + 3] * inv);
        c.x = pk_bf16(o1[4 * g] * inv, o1[4 * g + 1] * inv); c.y = pk_bf16(o1[4 * g + 2] * inv, o1[4 * g + 3] * inv);
        *(u32x2*)(og + 8 * g) = a; *(u32x2*)(og + 32 + 8 * g) = c;
        qs += sq2(a.x) + sq2(a.y) + sq2(c.x) + sq2(c.y);
    }
    qs += __shfl_xor(qs, 32);
    if (h == 0) atomicAdd(sg + tokbase + qpos, (unsigned long long)(qs * 16777216.f));
}

__device__ __forceinline__ void attn_b_unit(LAS unsigned char* lds, const bf16_t* proj, const bf16_t* vt, bf16_t* obuf, int b, int hk, int blk, const float* btab, unsigned long long* sg, bool build_lut, CP WP, int wlayer, int wbase) {
    int tid_ = threadIdx.x; asm volatile("" : "+v"(tid_));
    const int tid = tid_, lane = tid & 63, r = lane & 31, h = lane >> 5;
    const int w = __builtin_amdgcn_readfirstlane(tid >> 6);
    WItem wiA, wiB; f32x4 wva[8], wvb[8]; bool whA = false, whB = false;
    if (wlayer >= 0) { int l_, r_;
        whA = witem_att(wlayer, wbase + 2 * w, l_, r_); if (whA) { witem_desc(WP, l_, r_, lane, wiA); witem_load(wiA, wva); }
        whB = witem_att(wlayer, wbase + 2 * w + 1, l_, r_); if (whB) { witem_desc(WP, l_, r_, lane, wiB); witem_load(wiB, wvb); } }
    const int R0 = 4 * blk, ra = R0 + 2 * (w >> 2), m = w & 3;
    const int rq = ra + (r >> 4), c = 16 * m + (r & 15), qpos = rq * 64 + c;
    const int kc0 = clampi(16 * m - 8, 0, 32);
    const int qcol = QB_OFF + 64 * hk, kcol = KB_OFF + 64 * hk, vslot = 2 + hk, ocol = 512 + 64 * hk;
    const int T0 = clampi(R0 - 4, 0, 120), T1 = clampi(R0 - 1, 0, 120) + 7;
    const int wlo = clampi(ra - 4, 0, 120), whi = clampi(ra - 3, 0, 120) + 7;
    const int rsq = clampi(rq - 4, 0, 120);
    LAS float* bias = (LAS float*)(lds + ATT_BIAS);
    if (build_lut) for (int idx = tid; idx < 16 * 128; idx += 512) { const int dr = idx >> 7, y = idx & 127; bias[idx] = dr < 15 ? btab[(hk * 15 + dr) * 31 + clampi(y - 48, 0, 30)] * LOG2E : NEGBIG; }
    float pen[16];
    { const int cs = clampi(c - 8, 0, 48);
#pragma unroll
      for (int i = 0; i < 16; ++i) { const int kc = kc0 + 16 * (i >> 3) + 8 * h + (i & 7); pen[i] = (kc >= cs && kc < cs + 16) ? 0.f : NEGBIG; } }
    const size_t tokbase = (size_t)b * SEQ;
    const int srow = tid >> 3, sch = tid & 7;
    const bf16_t* kg = proj + (tokbase + srow) * INW + kcol + sch * 8;
    const bf16_t* vg = vt + ((size_t)(b * NVS + vslot) * 64 + srow) * SEQ + sch * 8;
    const unsigned sdst = srow * KP + sch * 16;
    u32x4 kreg, vreg;
    const bf16_t* qg = proj + (tokbase + qpos) * INW + qcol + 8 * h;
    bf16x8 qf[4];
#pragma unroll
    for (int ks = 0; ks < 4; ++ks) qf[ks] = *(const bf16x8*)(qg + 16 * ks);
    float mrun = -1e29f, l = 0.f;
    f32x16 o0, o1;
#pragma unroll
    for (int i = 0; i < 16; ++i) { o0[i] = 0.f; o1[i] = 0.f; }
    const int pr = (r & ~12) | ((r & 4) << 1) | ((r & 8) >> 1);
    const int nT = T1 - T0 + 1;
    kreg = *(const u32x4*)(kg + (size_t)(T0 * 64) * INW); vreg = *(const u32x4*)(vg + T0 * 64);
    *(LAS u32x4*)(lds + ATT_K + sdst) = kreg; *(LAS u32x4*)(lds + ATT_V + sdst) = vreg;
    __syncthreads();
    for (int it = 0; it < nT; ++it) {
        const int T = T0 + it, buf = it & 1;
        if (it + 1 < nT) { kreg = *(const u32x4*)(kg + (size_t)((T + 1) * 64) * INW); vreg = *(const u32x4*)(vg + (T + 1) * 64); }
        if (T >= wlo && T <= whi) {
            const LAS unsigned char* kb = lds + ATT_K + buf * ATT_TILE + (kc0 + pr) * KP + 16 * h;
            f32x16 s0;
#pragma unroll
            for (int i = 0; i < 16; ++i) s0[i] = 0.f;
#pragma unroll
            for (int ks = 0; ks < 4; ++ks) s0 = __builtin_amdgcn_mfma_f32_32x32x16_bf16(*(const LAS bf16x8*)(kb + 32 * ks), qf[ks], s0, 0, 0, 0);
            const int dr = (T >= rsq && T < rsq + 8) ? T - rq + 7 : 15;
            const LAS float* bh = bias + dr * 128 + (kc0 + 8 * h - c + 63);
#pragma unroll
            for (int i = 0; i < 16; ++i) s0[i] = (s0[i] * C2 + bh[16 * (i >> 3) + (i & 7)]) + pen[i];
            float mx = s0[0];
#pragma unroll
            for (int i = 1; i < 16; ++i) mx = fmaxf(mx, s0[i]);
            mx = fmaxf(mx, __shfl_xor(mx, 32));
            const float mnew = fmaxf(mrun, mx);
            const float alpha = __builtin_amdgcn_exp2f(mrun - mnew);
            mrun = mnew;
            float ps = 0.f;
#pragma unroll
            for (int i = 0; i < 16; ++i) { s0[i] = __builtin_amdgcn_exp2f(s0[i] - mnew); ps += s0[i]; }
            l = l * alpha + ps;
#pragma unroll
            for (int i = 0; i < 16; ++i) { o0[i] *= alpha; o1[i] *= alpha; }
            u32x4 pw[2];
#pragma unroll
            for (int q = 0; q < 4; ++q) { pw[0][q] = pk_bf16(s0[2 * q], s0[2 * q + 1]); pw[1][q] = pk_bf16(s0[8 + 2 * q], s0[8 + 2 * q + 1]); }
            const LAS unsigned char* vb = lds + ATT_V + buf * ATT_TILE + r * KP + 2 * kc0 + 16 * h;
#pragma unroll
            for (int ks = 0; ks < 2; ++ks) {
                const bf16x8 a0 = *(const LAS bf16x8*)(vb + 32 * ks), a1 = *(const LAS bf16x8*)(vb + 32 * KP + 32 * ks);
                const bf16x8 pf = __builtin_bit_cast(bf16x8, pw[ks]);
                o0 = __builtin_amdgcn_mfma_f32_32x32x16_bf16(a0, pf, o0, 0, 0, 0);
                o1 = __builtin_amdgcn_mfma_f32_32x32x16_bf16(a1, pf, o1, 0, 0, 0);
            }
        }
        if (it + 1 < nT) { *(LAS u32x4*)(lds + ATT_K + (buf ^ 1) * ATT_TILE + sdst) = kreg; *(LAS u32x4*)(lds + ATT_V + (buf ^ 1) * ATT_TILE + sdst) = vreg; }
        __syncthreads();
    }
    if (whA) witem_finish(wiA, wva);
    if (whB) witem_finish(wiB, wvb);
    l += __shfl_xor(l, 32);
    const float inv = 1.f / l;
    bf16_t* og = obuf + (tokbase + qpos) * DM + ocol + 4 * h;
    float qs = 0.f;
#pragma unroll
    for (int g = 0; g < 4; ++g) {
        u32x2 a, cc;
        a.x = pk_bf16(o0[4 * g] * inv, o0[4 * g + 1] * inv); a.y = pk_bf16(o0[4 * g + 2] * inv, o0[4 * g + 3] * inv);
        cc.x = pk_bf16(o1[4 * g] * inv, o1[4 * g + 1] * inv); cc.y = pk_bf16(o1[4 * g + 2] * inv, o1[4 * g + 3] * inv);
        *(u32x2*)(og + 8 * g) = a; *(u32x2*)(og + 32 + 8 * g) = cc;
        qs += sq2(a.x) + sq2(a.y) + sq2(cc.x) + sq2(cc.y);
    }
    qs += __shfl_xor(qs, 32);
    if (h == 0) atomicAdd(sg + tokbase + qpos, (unsigned long long)(qs * 16777216.f));
}

__device__ __forceinline__ void attn_c_unit(LAS unsigned char* lds, const bf16_t* proj, const bf16_t* vt, bf16_t* obuf, int b, int hk, int blk, float mref, unsigned long long* sg) {
    int tid_ = threadIdx.x; asm volatile("" : "+v"(tid_));
    const int tid = tid_, lane = tid & 63, r = lane & 31, h = lane >> 5;
    const int w = __builtin_amdgcn_readfirstlane(tid >> 6);
    const int qhead = 4 * hk + (w >> 1), qpos = blk * 128 + 64 * (w & 1) + r, qcol = QC_OFF + 64 * qhead, kcol = KC_OFF + 64 * hk, vslot = 10 + hk, ocol = 1024 + 64 * qhead;
    const size_t tokbase = (size_t)b * SEQ;
    const int srow = tid >> 3, sch = tid & 7;
    const bf16_t* kg = proj + (tokbase + srow) * INW + kcol + sch * 8;
    const bf16_t* vg = vt + ((size_t)(b * NVS + vslot) * 64 + srow) * SEQ + sch * 8;
    const unsigned sdst = srow * KP + sch * 16;
    u32x4 kreg, vreg;
    const bf16_t* qg = proj + (tokbase + qpos) * INW + qcol + 8 * h;
    bf16x8 qf[2][4];
#pragma unroll
    for (int j = 0; j < 2; ++j)
#pragma unroll
        for (int ks = 0; ks < 4; ++ks) qf[j][ks] = *(const bf16x8*)(qg + (size_t)(32 * j) * INW + 16 * ks);
    f32x16 negm;
#pragma unroll
    for (int i = 0; i < 16; ++i) negm[i] = 0.f;
    float l0 = 0.f, l1 = 0.f;
    f32x16 o00, o01, o10, o11;
#pragma unroll
    for (int i = 0; i < 16; ++i) { o00[i] = 0.f; o01[i] = 0.f; o10[i] = 0.f; o11[i] = 0.f; }
    const int pr = (r & ~12) | ((r & 4) << 1) | ((r & 8) >> 1);
    constexpr int nT = SEQ / 64;
    constexpr int CK = 0, CV = 4 * ATT_TILE;
#pragma unroll
    for (int i = 0; i < 2; ++i) { kreg = *(const u32x4*)(kg + (size_t)(i * 64) * INW); vreg = *(const u32x4*)(vg + i * 64);
        *(LAS u32x4*)(lds + CK + i * ATT_TILE + sdst) = kreg; *(LAS u32x4*)(lds + CV + i * ATT_TILE + sdst) = vreg; }
    __syncthreads();
    for (int it = 0; it < nT; ++it) {
        const int buf = it & 3;
        if (it + 2 < nT) { kreg = *(const u32x4*)(kg + (size_t)((it + 2) * 64) * INW); vreg = *(const u32x4*)(vg + (it + 2) * 64); }
        const LAS unsigned char* kb = lds + CK + buf * ATT_TILE + pr * KP + 16 * h;
        f32x16 s00, s01, s10, s11;
        {
            const bf16x8 a0 = *(const LAS bf16x8*)(kb), a1 = *(const LAS bf16x8*)(kb + 32 * KP);
            s00 = __builtin_amdgcn_mfma_f32_32x32x16_bf16(a0, qf[0][0], negm, 0, 0, 0);
            s10 = __builtin_amdgcn_mfma_f32_32x32x16_bf16(a0, qf[1][0], negm, 0, 0, 0);
            s01 = __builtin_amdgcn_mfma_f32_32x32x16_bf16(a1, qf[0][0], negm, 0, 0, 0);
            s11 = __builtin_amdgcn_mfma_f32_32x32x16_bf16(a1, qf[1][0], negm, 0, 0, 0);
        }
#pragma unroll
        for (int ks = 1; ks < 4; ++ks) {
            const bf16x8 a0 = *(const LAS bf16x8*)(kb + 32 * ks), a1 = *(const LAS bf16x8*)(kb + 32 * KP + 32 * ks);
            s00 = __builtin_amdgcn_mfma_f32_32x32x16_bf16(a0, qf[0][ks], s00, 0, 0, 0);
            s10 = __builtin_amdgcn_mfma_f32_32x32x16_bf16(a0, qf[1][ks], s10, 0, 0, 0);
            s01 = __builtin_amdgcn_mfma_f32_32x32x16_bf16(a1, qf[0][ks], s01, 0, 0, 0);
            s11 = __builtin_amdgcn_mfma_f32_32x32x16_bf16(a1, qf[1][ks], s11, 0, 0, 0);
        }
        u32x4 pw0[4], pw1[4];
        {
            float ps = 0.f;
#pragma unroll
            for (int i = 0; i < 16; ++i) { s00[i] = __builtin_amdgcn_exp2f(s00[i]); s01[i] = __builtin_amdgcn_exp2f(s01[i]); ps += s00[i] + s01[i]; }
            l0 += ps;
#pragma unroll
            for (int q = 0; q < 4; ++q) { pw0[0][q] = pk_bf16(s00[2 * q], s00[2 * q + 1]); pw0[1][q] = pk_bf16(s00[8 + 2 * q], s00[8 + 2 * q + 1]);
                                          pw0[2][q] = pk_bf16(s01[2 * q], s01[2 * q + 1]); pw0[3][q] = pk_bf16(s01[8 + 2 * q], s01[8 + 2 * q + 1]); }
        }
        {
            float ps = 0.f;
#pragma unroll
            for (int i = 0; i < 16; ++i) { s10[i] = __builtin_amdgcn_exp2f(s10[i]); s11[i] = __builtin_amdgcn_exp2f(s11[i]); ps += s10[i] + s11[i]; }
            l1 += ps;
#pragma unroll
            for (int q = 0; q < 4; ++q) { pw1[0][q] = pk_bf16(s10[2 * q], s10[2 * q + 1]); pw1[1][q] = pk_bf16(s10[8 + 2 * q], s10[8 + 2 * q + 1]);
                                          pw1[2][q] = pk_bf16(s11[2 * q], s11[2 * q + 1]); pw1[3][q] = pk_bf16(s11[8 + 2 * q], s11[8 + 2 * q + 1]); }
        }
        const LAS unsigned char* vb = lds + CV + buf * ATT_TILE + r * KP + 16 * h;
#pragma unroll
        for (int ks = 0; ks < 4; ++ks) {
            const bf16x8 a0 = *(const LAS bf16x8*)(vb + 32 * ks), a1 = *(const LAS bf16x8*)(vb + 32 * KP + 32 * ks);
            const bf16x8 p0 = __builtin_bit_cast(bf16x8, pw0[ks]), p1 = __builtin_bit_cast(bf16x8, pw1[ks]);
            o00 = __builtin_amdgcn_mfma_f32_32x32x16_bf16(a0, p0, o00, 0, 0, 0);
            o10 = __builtin_amdgcn_mfma_f32_32x32x16_bf16(a0, p1, o10, 0, 0, 0);
            o01 = __builtin_amdgcn_mfma_f32_32x32x16_bf16(a1, p0, o01, 0, 0, 0);
            o11 = __builtin_amdgcn_mfma_f32_32x32x16_bf16(a1, p1, o11, 0, 0, 0);
        }
        if (it + 2 < nT) { *(LAS u32x4*)(lds + CK + (buf ^ 2) * ATT_TILE + sdst) = kreg; *(LAS u32x4*)(lds + CV + (buf ^ 2) * ATT_TILE + sdst) = vreg; }
        if (it & 1) __syncthreads();
    }
    l0 += __shfl_xor(l0, 32); l1 += __shfl_xor(l1, 32);
    const float inv0 = 1.f / l0, inv1 = 1.f / l1;
    bf16_t* og = obuf + (tokbase + qpos) * DM + ocol + 4 * h;
    float qs0 = 0.f, qs1 = 0.f;
#pragma unroll
    for (int g = 0; g < 4; ++g) {
        u32x2 a, c;
        a.x = pk_bf16(o00[4 * g] * inv0, o00[4 * g + 1] * inv0); a.y = pk_bf16(o00[4 * g + 2] * inv0, o00[4 * g + 3] * inv0);
        c.x = pk_bf16(o01[4 * g] * inv0, o01[4 * g + 1] * inv0); c.y = pk_bf16(o01[4 * g + 2] * inv0, o01[4 * g + 3] * inv0);
        *(u32x2*)(og + 8 * g) = a; *(u32x2*)(og + 32 + 8 * g) = c;
        qs0 += sq2(a.x) + sq2(a.y) + sq2(c.x) + sq2(c.y);
        a.x = pk_bf16(o10[4 * g] * inv1, o10[4 * g + 1] * inv1); a.y = pk_bf16(o10[4 * g + 2] * inv1, o10[4 * g + 3] * inv1);
        c.x = pk_bf16(o11[4 * g] * inv1, o11[4 * g + 1] * inv1); c.y = pk_bf16(o11[4 * g + 2] * inv1, o11[4 * g + 3] * inv1);
        *(u32x2*)(og + (size_t)32 * DM + 8 * g) = a; *(u32x2*)(og + (size_t)32 * DM + 32 + 8 * g) = c;
        qs1 += sq2(a.x) + sq2(a.y) + sq2(c.x) + sq2(c.y);
    }
    qs0 += __shfl_xor(qs0, 32); qs1 += __shfl_xor(qs1, 32);
    if (h == 0) { atomicAdd(sg + tokbase + qpos, (unsigned long long)(qs0 * 16777216.f)); atomicAdd(sg + tokbase + qpos + 32, (unsigned long long)(qs1 * 16777216.f)); }
}

__device__ __forceinline__ void attn_phase(CP P, LAS unsigned char* lds, int layer) {
    const bf16_t* proj = (const bf16_t*)(P->ws + WS_PROJ); const bf16_t* vt = (const bf16_t*)(P->ws + WS_VT); bf16_t* obuf = (bf16_t*)(P->ws + WS_O);
    const int G = gridDim.x;
    unsigned long long* sgA = (unsigned long long*)(P->ws + WS_SG) + (size_t)(3 * layer) * MTOK; unsigned long long* sgB = sgA + MTOK; unsigned long long* sgC = sgB + MTOK;
    {
        float gq = 0.f, gk = 0.f;
        for (int d = 0; d < 64; ++d) { gq = fmaxf(gq, fabsf(P->c_q_gain[layer * 64 + d])); gk = fmaxf(gk, fabsf(P->c_k_gain[layer * 64 + d])); }
        const float bound = 64.f * C2 * gq * gk;
        if (bound < 60.f) {
            for (int u = blockIdx.x; u < 8 * 64; u += G) attn_c_unit(lds, proj, vt, obuf, (u & 7) >> 2, u & 3, u >> 3, 0.f, sgC);
        } else {
            for (int u = blockIdx.x; u < 8 * 128; u += G) attn_unit<2>(lds, proj, vt, obuf, (u & 7) >> 2, u & 3, u >> 3, nullptr, nullptr, sgC, false, P, -1, 0);
        }
    }
    { int prev = -1; for (int u = blockIdx.x; u < 4 * 128; u += G) { attn_unit<0>(lds, proj, vt, obuf, (u & 3) >> 1, u & 1, u >> 2, P->t5, P->a_sink + layer * 8, sgA, (u & 1) != prev, P, layer, u * 16); prev = u & 1; } }
    { int prev = -1; for (int u = blockIdx.x; u < 16 * 32; u += G) { attn_b_unit(lds, proj, vt, obuf, (u & 15) >> 3, u & 7, u >> 4, P->b_rpb + (size_t)layer * 8 * 15 * 31, sgB, (u & 7) != prev, P, layer, (512 + u) * 16); prev = u & 7; } }
}

__device__ __forceinline__ void mixnorm_phase(CP P, int layer) {
    int tid_ = threadIdx.x; asm volatile("" : "+v"(tid_));
    const int lane = tid_ & 63, wave = __builtin_amdgcn_readfirstlane(tid_ >> 6);
    const int gw = blockIdx.x * 8 + wave, NGW = gridDim.x * 8;
    const bf16_t* obuf = (const bf16_t*)(P->ws + WS_O); bf16_t* mix = (bf16_t*)(P->ws + WS_MIX);
    f32x4 g[4][2];
#pragma unroll
    for (int j = 0; j < 4; ++j) {
        const float* gp = (j == 0) ? P->og_a + layer * 512 + lane * 8 : (j == 1) ? P->og_b + layer * 512 + lane * 8 : P->og_c + layer * 1024 + (j - 2) * 512 + lane * 8;
        g[j][0] = *(const f32x4*)gp; g[j][1] = *(const f32x4*)(gp + 4);
    }
    for (int tok = gw; tok < MTOK; tok += NGW) {
        const u32x4* src = (const u32x4*)(obuf + (size_t)tok * DM) + lane;
        float v[4][8]; float ss[4];
#pragma unroll
        for (int j = 0; j < 4; ++j) { const u32x4 raw = src[64 * j]; ss[j] = 0.f;
#pragma unroll
            for (int q = 0; q < 4; ++q) { v[j][2 * q] = bf_lo(raw[q]); v[j][2 * q + 1] = bf_hi(raw[q]); ss[j] += v[j][2 * q] * v[j][2 * q] + v[j][2 * q + 1] * v[j][2 * q + 1]; } }
        const float sa = wave_sum(ss[0]), sb = wave_sum(ss[1]), sc = wave_sum(ss[2] + ss[3]);
        float rs[4]; rs[0] = rsqrtf(sa * (1.f / 512.f) + EPS); rs[1] = rsqrtf(sb * (1.f / 512.f) + EPS); rs[2] = rsqrtf(sc * (1.f / 1024.f) + EPS); rs[3] = rs[2];
        u32x4* dst = (u32x4*)(mix + (size_t)tok * DM) + lane;
#pragma unroll
        for (int j = 0; j < 4; ++j) { u32x4 wv;
            wv.x = pk_bf16(v[j][0] * rs[j] * g[j][0].x, v[j][1] * rs[j] * g[j][0].y); wv.y = pk_bf16(v[j][2] * rs[j] * g[j][0].z, v[j][3] * rs[j] * g[j][0].w);
            wv.z = pk_bf16(v[j][4] * rs[j] * g[j][1].x, v[j][5] * rs[j] * g[j][1].y); wv.w = pk_bf16(v[j][6] * rs[j] * g[j][1].z, v[j][7] * rs[j] * g[j][1].w);
            dst[64 * j] = wv; }
    }
}

typedef unsigned v4u __attribute__((ext_vector_type(4)));
#define XB_TMO      128
#define XB_XCNT(j)  (256  + 64 * (j))
#define XB_XSUB(j)  (1280 + 64 * (j))
#define XB_XGEN(j)  (2304 + 64 * (j))
#define XB_TOP      3328
#define XB_TOPGEN   3392
#define XCD_BAR_WORDS 3456
#define XB_SPIN_CAP (1u << 22)

__device__ __forceinline__ unsigned xb_ld(unsigned* p)              { return __hip_atomic_load(p, __ATOMIC_RELAXED, __HIP_MEMORY_SCOPE_AGENT); }
__device__ __forceinline__ unsigned xb_add(unsigned* p, unsigned v) { return __hip_atomic_fetch_add(p, v, __ATOMIC_RELAXED, __HIP_MEMORY_SCOPE_AGENT); }
__device__ __forceinline__ unsigned xb_xcc_id() { return (unsigned)__builtin_amdgcn_s_getreg((3 << 11) | 20) & 0xFu; }
#define XB_SPIN(cond, bar) do { unsigned _sp = 0; while (cond) { __builtin_amdgcn_s_sleep(1); \
    if ((++_sp & 255u) == 0u) { if (xb_ld(&(bar)[XB_TMO])) break; if (_sp > XB_SPIN_CAP) { atomicAdd(&(bar)[XB_TMO], 1u); break; } } } } while (0)

struct XcdBarrier {
    unsigned* bar; unsigned x;
    volatile LAS unsigned* st;
};

__device__ __forceinline__ XcdBarrier xcd_barrier_post(unsigned* bar, volatile LAS unsigned* st) {
    XcdBarrier b; b.bar = bar; b.x = xb_xcc_id(); b.st = st;
    if (threadIdx.x == 0) (void)xb_add(&bar[XB_XCNT(b.x)], 1u);
    return b;
}
__device__ __forceinline__ void xcd_barrier_complete(unsigned* bar, unsigned x, unsigned& nloc, unsigned& nx) {
    const unsigned G = gridDim.x * gridDim.y * gridDim.z;
    unsigned sum, cnt, mine, sp = 0u;
    for (;;) {
        sum = 0u; cnt = 0u; mine = 0u;
#pragma unroll
        for (unsigned j = 0; j < 16; ++j) { const unsigned c = xb_ld(&bar[XB_XCNT(j)]); sum += c; cnt += (c > 0u) ? 1u : 0u; mine = (j == x) ? c : mine; }
        if (sum == G) break;
        __builtin_amdgcn_s_sleep(1);
        if ((++sp & 255u) == 0u) { if (xb_ld(&bar[XB_TMO])) break; if (sp > XB_SPIN_CAP) { atomicAdd(&bar[XB_TMO], 1u); break; } }
    }
    nloc = mine > 0u ? mine : 1u; nx = cnt > 0u ? cnt : 1u;
}

__device__ __forceinline__ void xcd_barrier(const XcdBarrier& b) {
    asm volatile("s_waitcnt vmcnt(0)" ::: "memory");
    __syncthreads();
    if (threadIdx.x == 0) {
        unsigned* bar = b.bar;
        __builtin_amdgcn_s_waitcnt(0);
        unsigned nloc = b.st[0], nx = b.st[1];
        if (nloc == 0u) { xcd_barrier_complete(bar, b.x, nloc, nx); b.st[0] = nloc; b.st[1] = nx; }
        const unsigned old = xb_add(&bar[XB_XSUB(b.x)], 1u);
        const unsigned gen = old / nloc;
        if (old + 1u == (gen + 1u) * nloc) {
            __builtin_amdgcn_fence(__ATOMIC_RELEASE, "agent");
            asm volatile("s_waitcnt vmcnt(0)" ::: "memory");
            const unsigned og = xb_add(&bar[XB_TOP], 1u);
            const unsigned tg = og / nx;
            if (og + 1u == (tg + 1u) * nx) xb_add(&bar[XB_TOPGEN], 1u);
            else XB_SPIN(xb_ld(&bar[XB_TOPGEN]) == tg, bar);
            __builtin_amdgcn_fence(__ATOMIC_ACQUIRE, "agent");
            xb_add(&bar[XB_XGEN(b.x)], 1u);
            asm volatile("s_waitcnt vmcnt(0)" ::: "memory");
        } else {
            XB_SPIN(xb_ld(&bar[XB_XGEN(b.x)]) == gen, bar);
            __builtin_amdgcn_fence(__ATOMIC_ACQUIRE, "agent");
            asm volatile("s_waitcnt vmcnt(0)" ::: "memory");
        }
    }
    __syncthreads();
}

__global__ void __launch_bounds__(512, 2) hymba_fwd(Params Parg) {
    extern __shared__ __attribute__((aligned(16))) unsigned char lds_raw[];
    LAS unsigned char* lds = (LAS unsigned char*)lds_raw;
    cg::grid_group grid = cg::this_grid();
    volatile LAS unsigned* bar_st = (volatile LAS unsigned*)(lds + LDS_BYTES - 64);
    if (threadIdx.x < 2) bar_st[threadIdx.x] = 0u;
    __syncthreads();
    (void)xcd_barrier_post((unsigned*)(PP()->ws + WS_BAR), bar_st);
#define BUILD_RSTAB(S_, ssptr) do { pg8::Unit uu_; LAS float* t_ = (LAS float*)(lds + 131072); int tb_ = threadIdx.x; asm volatile("" : "+v"(tb_)); \
        _Pragma("unroll 1") for (int ui_ = 0; ui_ < 15 && (S_).next(ui_, uu_); ++ui_) \
            for (int rl_ = tb_; rl_ < 256; rl_ += 512) t_[ui_ * 256 + rl_] = rsqrtf((float)(ssptr)[(size_t)uu_.pm * 256 + rl_] * (1.f / (2048.f * 16777216.f)) + EPS); \
        __syncthreads(); } while (0)
#define GRID_BAR() do { XcdBarrier b_; b_.bar = (unsigned*)(PP()->ws + WS_BAR); b_.x = xb_xcc_id(); b_.st = bar_st; xcd_barrier(b_); } while (0)

    weights_phase(PP(), lds);
    { CP P = PP(); xinit_phase(P->x, (bf16_t*)(P->ws + WS_H), (unsigned long long*)(P->ws + WS_SS)); }
    grid.sync();
    for (int layer = 0; layer < DEPTH; ++layer) {
        {
            CP P = PP(); unsigned char* ws = P->ws;
            pg8::Gemm g{(const bf16_t*)(ws + WS_H), (const bf16_t*)(ws + WS_WIN + layer * SZ_WIN), MTOK, INW, DM}; pg8::StaticOrder S; S.init(MTOK, INW, gridDim.x, blockIdx.x);
            BUILD_RSTAB(S, (const unsigned long long*)(ws + WS_SS) + (size_t)(2 * layer) * MTOK);
            pg8::EpiInProj E{(bf16_t*)(ws + WS_PROJ), (bf16_t*)(ws + WS_VT), (const LAS float*)(lds + 131072), P->c_q_gain + layer * 64, P->c_k_gain + layer * 64};
            pg8::gemm_phase<pg8::EpiInProj, pg8::StaticOrder, true, true>(lds, g, S, E);
        }
        weights_deferred(PP(), layer);
        GRID_BAR();
        attn_phase(PP(), lds, layer);
        GRID_BAR();
        {
            CP P = PP(); unsigned char* ws = P->ws;
            pg8::Gemm g{(const bf16_t*)(ws + WS_O), (const bf16_t*)(ws + WS_WO + layer * SZ_WO), MTOK, DM, DM}; pg8::StaticOrder S; S.init(MTOK, DM, gridDim.x, blockIdx.x);
            LAS float* tab = (LAS float*)(lds + 131072);
            {
                const unsigned long long* sgA = (const unsigned long long*)(ws + WS_SG) + (size_t)(3 * layer) * MTOK;
                pg8::Unit uu;
                int tb_ = threadIdx.x; asm volatile("" : "+v"(tb_));
#pragma unroll 1
                for (int ui = 0; ui < 4 && S.next(ui, uu); ++ui)
                    for (int rl = tb_; rl < 256; rl += 512) { const size_t tok = (size_t)uu.pm * 256 + rl;
                        const float ra = rsqrtf((float)sgA[tok] * (1.f / (512.f * 16777216.f)) + EPS), rb = rsqrtf((float)sgA[MTOK + tok] * (1.f / (512.f * 16777216.f)) + EPS),
                                    rc = rsqrtf((float)sgA[2 * MTOK + tok] * (1.f / (1024.f * 16777216.f)) + EPS);
                        tab[(ui * 3 + 0) * 256 + rl] = ra / rb; tab[(ui * 3 + 1) * 256 + rl] = rb / rc; tab[(ui * 3 + 2) * 256 + rl] = rc; }
                __syncthreads();
            }
            pg8::EpiResBf16 E{(bf16_t*)(ws + WS_H), DM, (unsigned long long*)(ws + WS_SS) + (size_t)(2 * layer + 1) * MTOK};
            pg8::MixHook Hk{tab};
            pg8::gemm_phase<pg8::EpiResBf16, pg8::StaticOrder, true, true, pg8::MixHook>(lds, g, S, E, Hk);
        }
        GRID_BAR();
        {
            CP P = PP(); unsigned char* ws = P->ws;
            pg8::Gemm g{(const bf16_t*)(ws + WS_H), (const bf16_t*)(ws + WS_WUP + layer * SZ_WUP), MTOK, DFF, DM}; pg8::StaticOrder S; S.init(MTOK, DFF, gridDim.x, blockIdx.x);
            BUILD_RSTAB(S, (const unsigned long long*)(ws + WS_SS) + (size_t)(2 * layer + 1) * MTOK);
            pg8::EpiBf16<2> E{(bf16_t*)(ws + WS_U), DFF, (const LAS float*)(lds + 131072)};
            pg8::gemm_phase<pg8::EpiBf16<2>, pg8::StaticOrder, true, true>(lds, g, S, E);
        }
        GRID_BAR();
        {
            CP P = PP(); unsigned char* ws = P->ws;
            pg8::Gemm g{(const bf16_t*)(ws + WS_U), (const bf16_t*)(ws + WS_WDN + layer * SZ_WDN), MTOK, DM, DFF}; pg8::StaticOrder S; S.init(MTOK, DM, gridDim.x, blockIdx.x);
            pg8::EpiResBf16 E{(bf16_t*)(ws + WS_H), DM, (unsigned long long*)(ws + WS_SS) + (size_t)(2 * layer + 2) * MTOK};
            pg8::gemm_phase<pg8::EpiResBf16, pg8::StaticOrder, true, true, pg8::NoHook, true>(lds, g, S, E);
        }
        GRID_BAR();
    }
    { CP P = PP(); final_phase((const bf16_t*)(P->ws + WS_H), P->out, P->norm_final, (const unsigned long long*)(P->ws + WS_SS) + (size_t)(2 * DEPTH) * MTOK); }
}

extern "C" void kernel_launch(void* const* d_in, const int* in_sizes, int n_in, void* d_out, int out_size, void* d_ws, size_t ws_size, hipStream_t stream) {
    static int grid = 0;
    if (grid == 0) {
        if (n_in != 16 || in_sizes[0] != MTOK * DM || out_size != MTOK * DM || ws_size < WS_END) {
            fprintf(stderr, "kernel_launch: unexpected shapes (n_in %d, in0 %d, out %d, ws %zu need %zu)\n", n_in, n_in > 0 ? in_sizes[0] : -1, out_size, ws_size, (size_t)WS_END); grid = -1; return; }
        int dev = 0, cus = 0, per_cu = 0;
        hipGetDevice(&dev); hipDeviceGetAttribute(&cus, hipDeviceAttributeMultiprocessorCount, dev);
        if (hipFuncSetAttribute((const void*)hymba_fwd, hipFuncAttributeMaxDynamicSharedMemorySize, LDS_BYTES) != hipSuccess) fprintf(stderr, "kernel_launch: hipFuncSetAttribute failed\n");
        if (hipOccupancyMaxActiveBlocksPerMultiprocessor(&per_cu, (const void*)hymba_fwd, 512, LDS_BYTES) != hipSuccess || per_cu < 1) { fprintf(stderr, "kernel_launch: occupancy query gave %d\n", per_cu); per_cu = 1; }
        (void)hipGetLastError();
        grid = cus * per_cu;
        if (grid < 192) { fprintf(stderr, "kernel_launch: grid %d too small for this build (the LDS row-factor tables hold 4 out-projection / 15 up-projection tiles per workgroup)\n", grid); grid = -1; return; }
    }
    if (grid < 0) return;
    Params p{};
    p.x = (const float*)d_in[0]; p.norm_mix = (const float*)d_in[1]; p.w_in = (const float*)d_in[2]; p.a_sink = (const float*)d_in[3]; p.t5 = (const float*)d_in[4];
    p.b_rpb = (const float*)d_in[5]; p.c_q_gain = (const float*)d_in[6]; p.c_k_gain = (const float*)d_in[7]; p.og_a = (const float*)d_in[8]; p.og_b = (const float*)d_in[9];
    p.og_c = (const float*)d_in[10]; p.w_o = (const float*)d_in[11]; p.norm_mlp = (const float*)d_in[12]; p.w_up = (const float*)d_in[13]; p.w_down = (const float*)d_in[14];
    p.norm_final = (const float*)d_in[15]; p.out = (float*)d_out; p.ws = (unsigned char*)d_ws;
    if (hipMemsetAsync((char*)d_ws + WS_BAR, 0, 16384, stream) != hipSuccess) { fprintf(stderr, "kernel_launch: memset of the barrier words failed\n"); return; }
    void* args[] = {&p};
    hipError_t e = hipLaunchCooperativeKernel((const void*)hymba_fwd, dim3(grid), dim3(512), args, LDS_BYTES, stream);
    if (e != hipSuccess) fprintf(stderr, "kernel_launch: cooperative launch failed: %s (grid %d)\n", hipGetErrorString(e), grid);
}
```

```cpp
#include <hip/hip_runtime.h>
#include <hip/hip_cooperative_groups.h>
#include <cstdio>
#include <cstdint>
namespace cg = cooperative_groups;
namespace pg8 {
#define PG8_LAS __attribute__((address_space(3)))
typedef unsigned short bf16_t;
typedef short bf16x8 __attribute__((ext_vector_type(8)));
typedef float f32x4 __attribute__((ext_vector_type(4)));
typedef unsigned u32x4 __attribute__((ext_vector_type(4)));
constexpr int BM = 256, BK = 64, HALF = 128, HTB = HALF * BK * 2  , STAGE_BYTES = 8 * HTB, NXCD = 8, WGM = 8;

__host__ __device__ __forceinline__ int lds_byte(int r, int c) { const int st = (r >> 4) * 2 + (c >> 5), rr = r & 15, cc = c & 31, ob = rr * 64 + cc * 2; return st * 1024 + (ob ^ (((ob >> 9) & 1) << 5)); }
__host__ __device__ __forceinline__ void stage_rc(int b, int& R, int& C) { const int st = b / 1024, sb = b % 1024, swz = sb ^ (((sb >> 9) & 1) << 5); R = (st >> 1) * 16 + swz / 64; C = (st & 1) * 32 + (swz % 64) / 2; }
__host__ __device__ __forceinline__ int perm32(int rho) { const int n = rho >> 4, i = rho & 15; return 8 * (i >> 2) + 4 * n + (i & 3); }

struct Unit { int pm, pn; };
struct Gemm { const bf16_t* A; const bf16_t* Bt; int M, N, K; };

struct StaticOrder {
    int nM, nN, nwg, G, c;
    __host__ __device__ void init(int M, int N, int G_, int c_) { nM = M / BM; nN = N / BM; nwg = nM * nN; G = G_; c = c_; }
    __host__ __device__ bool next(int i, Unit& u) const {
        const long L = (long)i * G + c; if (L >= nwg) return false;
        int wgid = (int)L; { const int q = nwg / NXCD, r = nwg % NXCD, xcd = wgid % NXCD, off = wgid / NXCD; wgid = (xcd < r ? xcd * (q + 1) : r * (q + 1) + (xcd - r) * q) + off; }
        const int nig = WGM * nN, gid = wgid / nig, fm = gid * WGM, gsz = (nM - fm) < WGM ? (nM - fm) : WGM;
        u.pm = fm + ((wgid % nig) % gsz); u.pn = (wgid % nig) / gsz; return true;
    }
    __device__ __forceinline__ void a_ready(const Unit&) const {}
    __device__ __forceinline__ void done(const Unit&) const {}
};

typedef float f32x2_t __attribute__((ext_vector_type(2))); typedef __bf16 bf16x2_t __attribute__((ext_vector_type(2)));
__device__ __forceinline__ unsigned cvt_pk_bf16(float lo, float hi) { f32x2_t v = {lo, hi}; bf16x2_t b = __builtin_convertvector(v, bf16x2_t); return __builtin_bit_cast(unsigned, b); }

template <int ACT  > struct EpiBf16 {
    static constexpr bool PERM = true, AFTER_DRAIN = false;
    bf16_t* O; int ldc; const PG8_LAS float* rstab;
    __device__ __forceinline__ void operator()(const f32x4 (&acc)[2][2][4][2], const Unit& u, int wr, int wc, int fr, int fq, int ui) const {
        const int row0 = u.pm * BM + wr * 64 + fr; const int col0 = u.pn * BM + wc * 32 + 8 * fq;
#pragma unroll
        for (int ai = 0; ai < 2; ++ai)
#pragma unroll
            for (int m = 0; m < 4; ++m) { const int row = row0 + ai * HALF + m * 16; bf16_t* rowp = O + (size_t)row * ldc + col0;
                const float rs = rstab[ui * 256 + wr * 64 + fr + ai * HALF + m * 16];
#pragma unroll
                for (int bj = 0; bj < 2; ++bj) { f32x4 v0 = acc[ai][bj][m][0] * rs, v1 = acc[ai][bj][m][1] * rs;
                    if (ACT == 2) {
#pragma unroll
                        for (int e = 0; e < 4; ++e) { const float a = fmaxf(v0[e], 0.f), b = fmaxf(v1[e], 0.f); v0[e] = a * a; v1[e] = b * b; } }
                    u32x4 w; w.x = cvt_pk_bf16(v0[0], v0[1]); w.y = cvt_pk_bf16(v0[2], v0[3]); w.z = cvt_pk_bf16(v1[0], v1[1]); w.w = cvt_pk_bf16(v1[2], v1[3]);
                    *(u32x4*)(rowp + bj * HALF) = w; } }
    }
};
struct EpiInProj {
    static constexpr bool PERM = true, AFTER_DRAIN = false;
    bf16_t* O; bf16_t* VT; const PG8_LAS float* rstab; const float* qgain; const float* kgain;
    __device__ __forceinline__ void operator()(const f32x4 (&acc)[2][2][4][2], const Unit& u, int wr, int wc, int fr, int fq, int ui) const {
        constexpr int LDC = 3840, SEQL = 8192;
        const int pn = u.pn, row0 = u.pm * BM + wr * 64 + fr, colh = pn * BM + 64 * wc;
        int mode = 0, vslot = 0;
        if (pn >= 9 && pn <= 12) mode = 1; else if (pn == 13) mode = 2; else if (pn == 14) { mode = 3; vslot = 10 + wc; }
        else if (pn == 7 || pn == 8) { mode = 3; vslot = 2 + 4 * (pn - 7) + wc; } else if (pn == 2 && wc >= 2) { mode = 3; vslot = wc - 2; }
        if (mode == 0) {
#pragma unroll
            for (int ai = 0; ai < 2; ++ai)
#pragma unroll
                for (int m = 0; m < 4; ++m) { const int row = row0 + ai * HALF + m * 16; bf16_t* rowp = O + (size_t)row * LDC + colh + 8 * fq;
                    const float rs = rstab[ui * 256 + wr * 64 + fr + ai * HALF + m * 16];
#pragma unroll
                    for (int bj = 0; bj < 2; ++bj) { const f32x4 v0 = acc[ai][bj][m][0] * rs, v1 = acc[ai][bj][m][1] * rs;
                        u32x4 w; w.x = cvt_pk_bf16(v0[0], v0[1]); w.y = cvt_pk_bf16(v0[2], v0[3]); w.z = cvt_pk_bf16(v1[0], v1[1]); w.w = cvt_pk_bf16(v1[2], v1[3]);
                        *(u32x4*)(rowp + 32 * bj) = w; }
                    __builtin_amdgcn_sched_barrier(0); }
        } else if (mode == 3) {
#pragma unroll
            for (int ai = 0; ai < 2; ++ai)
#pragma unroll
                for (int m = 0; m < 4; ++m) { const int row = row0 + ai * HALF + m * 16;
                    const float rs = rstab[ui * 256 + wr * 64 + fr + ai * HALF + m * 16];
                    bf16_t* dst = VT + ((size_t)((row >> 13) * 14 + vslot) * 64 + 8 * fq) * SEQL + (row & (SEQL - 1));
#pragma unroll
                    for (int bj = 0; bj < 2; ++bj)
#pragma unroll
                        for (int n = 0; n < 2; ++n) { const f32x4 v = acc[ai][bj][m][n] * rs; const unsigned w0 = cvt_pk_bf16(v[0], v[1]), w1 = cvt_pk_bf16(v[2], v[3]);
                            bf16_t* dp = dst + (size_t)(32 * bj + 4 * n) * SEQL;
                            dp[0] = (bf16_t)(w0 & 0xffffu); dp[SEQL] = (bf16_t)(w0 >> 16); dp[2 * SEQL] = (bf16_t)(w1 & 0xffffu); dp[3 * SEQL] = (bf16_t)(w1 >> 16); }
                    __builtin_amdgcn_sched_barrier(0); }
        } else {
            const float* gp = (mode == 1 ? qgain : kgain) + 8 * fq;
            float g[2][8];
#pragma unroll
            for (int bj = 0; bj < 2; ++bj)
#pragma unroll
                for (int e = 0; e < 8; ++e) g[bj][e] = gp[32 * bj + e];
            const float osc = (mode == 1) ? 0.125f * 1.4426950408889634f : 1.f;
            const float fsc = (fq & 1) ? 0.01f : 1.f;
            const float sgn = (fq < 2) ? -1.f : 1.f;
#pragma unroll
            for (int ai = 0; ai < 2; ++ai)
#pragma unroll
                for (int m = 0; m < 4; ++m) { const int row = row0 + ai * HALF + m * 16; bf16_t* rowp = O + (size_t)row * LDC + colh + 8 * fq;
                    const float rs = rstab[ui * 256 + wr * 64 + fr + ai * HALF + m * 16];
                    float x[2][8]; float q = 0.f;
#pragma unroll
                    for (int bj = 0; bj < 2; ++bj)
#pragma unroll
                        for (int e = 0; e < 8; ++e) { x[bj][e] = acc[ai][bj][m][e >> 2][e & 3] * rs; q += x[bj][e] * x[bj][e]; }
                    q += __shfl_xor(q, 16); q += __shfl_xor(q, 32);
                    const float rr = __builtin_amdgcn_rsqf(q * (1.f / 64.f) + 1e-6f) * osc;
                    int pos = row & (SEQL - 1); asm volatile("" : "+v"(pos));
#pragma unroll
                    for (int bj = 0; bj < 2; ++bj) { const float axv = (float)(bj ? (pos & 63) : (pos >> 6)) * fsc; float o[8];
#pragma unroll
                        for (int e = 0; e < 8; ++e) { const float y = x[bj][e] * rr * g[bj][e]; const float p = __shfl_xor(y, 32);
                            const float fr_ = (e == 0 ? 1.f : e == 1 ? 0.5623413251903491f : e == 2 ? 0.31622776601683794f : e == 3 ? 0.1778279410038923f : e == 4 ? 0.1f : e == 5 ? 0.05623413251903491f : e == 6 ? 0.031622776601683794f : 0.01778279410038923f);
                            const float ang = axv * fr_ * 0.15915494309189535f;
                            const float cs = __builtin_amdgcn_cosf(ang), sn = __builtin_amdgcn_sinf(ang);
                            o[e] = y * cs + sgn * p * sn; }
                        u32x4 w; w.x = cvt_pk_bf16(o[0], o[1]); w.y = cvt_pk_bf16(o[2], o[3]); w.z = cvt_pk_bf16(o[4], o[5]); w.w = cvt_pk_bf16(o[6], o[7]);
                        *(u32x4*)(rowp + 32 * bj) = w; }
                    __builtin_amdgcn_sched_barrier(0); }
        }
    }
};
typedef unsigned u32x2 __attribute__((ext_vector_type(2)));
struct EpiResBf16 {
    static constexpr bool PERM = true, AFTER_DRAIN = false;
    bf16_t* xb; int ldc; unsigned long long* ssq;
    __device__ __forceinline__ void operator()(const f32x4 (&acc)[2][2][4][2], const Unit& u, int wr, int wc, int fr, int fq, int ui) const {
        const int row0 = u.pm * BM + wr * 64 + fr; const int col0 = u.pn * BM + wc * 32 + 8 * fq;
#pragma unroll
        for (int ai = 0; ai < 2; ++ai) {
            u32x4 bs[4][2];
#pragma unroll
            for (int m = 0; m < 4; ++m) { const bf16_t* rowp = xb + (size_t)(row0 + ai * HALF + m * 16) * ldc + col0;
#pragma unroll
                for (int bj = 0; bj < 2; ++bj) bs[m][bj] = *(const u32x4*)(rowp + bj * HALF); }
#pragma unroll
            for (int m = 0; m < 4; ++m) { const int row = row0 + ai * HALF + m * 16; bf16_t* rowp = xb + (size_t)row * ldc + col0;
                float q = 0.f;
#pragma unroll
                for (int bj = 0; bj < 2; ++bj) { u32x4 w;
#pragma unroll
                    for (int p = 0; p < 4; ++p) { const f32x4 a = acc[ai][bj][m][p >> 1]; const unsigned b = bs[m][bj][p];
                        const float lo = __uint_as_float(b << 16) + a[2 * (p & 1)], hi = __uint_as_float(b & 0xffff0000u) + a[2 * (p & 1) + 1];
                        const unsigned pk = cvt_pk_bf16(lo, hi); w[p] = pk;
                        const float rl = __uint_as_float(pk << 16), rh = __uint_as_float(pk & 0xffff0000u); q += rl * rl + rh * rh; }
                    *(u32x4*)(rowp + bj * HALF) = w; }
                q += __shfl_xor(q, 16); q += __shfl_xor(q, 32);
                if (fq == 0) atomicAdd(ssq + row, (unsigned long long)(q * 16777216.f)); }
            asm volatile("" ::: "memory");
        }
    }
};

struct NoHook { static constexpr bool ENABLED = false; __device__ __forceinline__ void operator()(f32x4 (&)[2][2][4][2], int, int, int, int, int) const {} };
struct MixHook { static constexpr bool ENABLED = true; const PG8_LAS float* tab;
    __device__ __forceinline__ void operator()(f32x4 (&acc)[2][2][4][2], int t, int nt, int ui, int wr, int fr) const {
        int sel; if (t == 8) sel = 0; else if (t == 16) sel = 1; else if (t == nt) sel = 2; else return;
        const PG8_LAS float* f = tab + (ui * 3 + sel) * 256 + wr * 64 + fr;
#pragma unroll
        for (int ai = 0; ai < 2; ++ai)
#pragma unroll
            for (int m = 0; m < 4; ++m) { const float sc = f[ai * HALF + m * 16];
#pragma unroll
                for (int bj = 0; bj < 2; ++bj)
#pragma unroll
                    for (int n = 0; n < 2; ++n) acc[ai][bj][m][n] = acc[ai][bj][m][n] * sc; }
    }
};
template <class Epi, class Sched, bool ALIGN_EPI = false, bool SP2 = false, class Hook = NoHook, bool REVK = false>
__device__ __forceinline__ void gemm_phase(PG8_LAS unsigned char* lds, const Gemm g, const Sched& S, const Epi& E, const Hook H = Hook()) {
    int tid_ = threadIdx.x; asm volatile("" : "+v"(tid_));
    const int tid = tid_, wid = __builtin_amdgcn_readfirstlane(tid >> 6), lane = tid & 63, wr = wid >> 2, wc = wid & 3, fr = lane & 15, fq = lane >> 4;
    const int K = g.K, nt = K / BK;
    unsigned voffA[2], voffB[2];
#pragma unroll
    for (int i = 0; i < 2; ++i) { int R, C; stage_rc(tid * 16 + i * 8192, R, C); const int Rb = Epi::PERM ? ((R & ~31) + perm32(R & 31)) : R;
        voffA[i] = (unsigned)(R * K + C) * 2u; voffB[i] = (unsigned)(Rb * K + C) * 2u; }
    const long kstep = REVK ? -(long)(BK * 2) : (long)(BK * 2);
    const size_t krev = REVK ? (size_t)(K / BK - 1) * (size_t)(BK * 2) : 0;
    const size_t hstep = (size_t)HALF * K * 2;
    const size_t tstep = 2 * hstep;
    const unsigned ldsw = (unsigned)wid * 1024u;
    const int aoff = lds_byte(wr * 64 + fr, fq * 8), boff = lds_byte(wc * 32 + fr, fq * 8);
#define PG8_SA(b, h) (((b) * 2 + (h)) * HTB)
#define PG8_SB(b, h) ((4 + (b) * 2 + (h)) * HTB)
#define PG8_STAGE(bufoff, gbase, voff) do { _Pragma("unroll") for (int _i = 0; _i < 2; ++_i) \
        __builtin_amdgcn_global_load_lds((const unsigned*)((const char*)(gbase) + (voff)[_i]), (PG8_LAS unsigned*)(lds + (bufoff) + ldsw + _i * 8192), 16, 0, 0); } while (0)
#define PG8_LDA(dst, b, h) do { _Pragma("unroll") for (int m = 0; m < 4; ++m) _Pragma("unroll") for (int k = 0; k < 2; ++k) dst[m][k] = *(const PG8_LAS bf16x8*)(lds + PG8_SA(b, h) + aoff + m * 2048 + k * 1024); } while (0)
#define PG8_LDB(dst, b, h) do { _Pragma("unroll") for (int n = 0; n < 2; ++n) _Pragma("unroll") for (int k = 0; k < 2; ++k) dst[n][k] = *(const PG8_LAS bf16x8*)(lds + PG8_SB(b, h) + boff + n * 2048 + k * 1024); } while (0)
#define PG8_MMA(ai, bj, At, Bt) do { __builtin_amdgcn_s_setprio(1); _Pragma("unroll") for (int m = 0; m < 4; ++m) _Pragma("unroll") for (int n = 0; n < 2; ++n) _Pragma("unroll") for (int k = 0; k < 2; ++k) \
        acc[ai][bj][m][n] = __builtin_amdgcn_mfma_f32_16x16x32_bf16(Bt[n][k], At[m][k], acc[ai][bj][m][n], 0, 0, 0); __builtin_amdgcn_s_setprio(0); } while (0)
#define PG8_WAIT_V(n) asm volatile("s_waitcnt vmcnt(" #n ")" ::: "memory")
#define PG8_WAIT_L(n) asm volatile("s_waitcnt lgkmcnt(" #n ")" ::: "memory")
#define PG8_BAR __builtin_amdgcn_s_barrier()
#define PG8_SCHED __builtin_amdgcn_sched_barrier(0)
    Unit cur, nxt; int ui = 0;
    if (!S.next(0, cur)) return;
    f32x4 acc[2][2][4][2];
#pragma unroll
    for (int a = 0; a < 2; ++a)
#pragma unroll
        for (int b = 0; b < 2; ++b)
#pragma unroll
            for (int m = 0; m < 4; ++m)
#pragma unroll
                for (int n = 0; n < 2; ++n) acc[a][b][m][n] = (f32x4){0.f, 0.f, 0.f, 0.f};
    bf16x8 At[4][2], B0[2][2], B1[2][2];
    const char* cA = (const char*)g.A + (size_t)cur.pm * tstep + krev; const char* cB = (const char*)g.Bt + (size_t)cur.pn * tstep + krev;
    S.a_ready(cur);
    if constexpr (SP2) {
        PG8_STAGE(PG8_SB(0, 0), cB, voffB); PG8_STAGE(PG8_SB(0, 1), cB + hstep, voffB); PG8_STAGE(PG8_SA(0, 0), cA, voffA); PG8_STAGE(PG8_SA(0, 1), cA + hstep, voffA);
        if (wr == 1) PG8_BAR;
        PG8_WAIT_V(2); PG8_BAR;
        PG8_STAGE(PG8_SB(1, 0), cB + kstep, voffB); PG8_STAGE(PG8_SA(1, 0), cA + kstep, voffA); PG8_STAGE(PG8_SB(1, 1), cB + hstep + kstep, voffB);
        PG8_WAIT_V(6); PG8_BAR;
    } else {
        PG8_STAGE(PG8_SB(0, 0), cB, voffB); PG8_STAGE(PG8_SA(0, 0), cA, voffA); PG8_STAGE(PG8_SB(0, 1), cB + hstep, voffB); PG8_STAGE(PG8_SA(0, 1), cA + hstep, voffA);
        if (wr == 1) PG8_BAR;
        PG8_WAIT_V(4); PG8_BAR;
        PG8_STAGE(PG8_SB(1, 0), cB + kstep, voffB); PG8_STAGE(PG8_SA(1, 0), cA + kstep, voffA); PG8_STAGE(PG8_SB(1, 1), cB + hstep + kstep, voffB);
        PG8_WAIT_V(6); PG8_BAR;
    }
    for (;;) {
        const bool has_next = S.next(ui + 1, nxt);
        const char* nA = has_next ? (const char*)g.A + (size_t)nxt.pm * tstep + krev : cA; const char* nB = has_next ? (const char*)g.Bt + (size_t)nxt.pn * tstep + krev : cB;
        for (int t = 0; t < nt; t += 2) {
            if constexpr (Hook::ENABLED) H(acc, t, nt, ui, wr, fr);
            const bool last = (t == nt - 2);
            const char* a1 = cA + (long)(t + 1) * kstep;
            const char* a2 = last ? nA : cA + (long)(t + 2) * kstep; const char* b2 = last ? nB : cB + (long)(t + 2) * kstep;
            const char* a3 = a2 + kstep; const char* b3 = b2 + kstep;
            if (last && has_next) S.a_ready(nxt);
            if constexpr (SP2) {
            PG8_LDB(B0, 0, 0); PG8_LDB(B1, 0, 1); PG8_SCHED; PG8_LDA(At, 0, 0); PG8_STAGE(PG8_SA(1, 1), a1 + hstep, voffA);
            PG8_WAIT_V(8); PG8_WAIT_L(0); PG8_BAR; PG8_MMA(0, 0, At, B0); PG8_MMA(0, 1, At, B1); PG8_BAR; PG8_SCHED;
            PG8_LDA(At, 0, 1); PG8_STAGE(PG8_SB(0, 0), b2, voffB); PG8_STAGE(PG8_SB(0, 1), b2 + hstep, voffB); PG8_STAGE(PG8_SA(0, 0), a2, voffA);
            PG8_WAIT_V(8); PG8_WAIT_L(0); PG8_BAR; PG8_MMA(1, 0, At, B0); PG8_MMA(1, 1, At, B1); PG8_BAR; PG8_SCHED;
            PG8_LDB(B0, 1, 0); PG8_LDB(B1, 1, 1); PG8_SCHED; PG8_LDA(At, 1, 0); PG8_STAGE(PG8_SA(0, 1), a2 + hstep, voffA);
            PG8_WAIT_V(8); PG8_WAIT_L(0); PG8_BAR; PG8_MMA(0, 0, At, B0); PG8_MMA(0, 1, At, B1); PG8_BAR; PG8_SCHED;
            PG8_LDA(At, 1, 1); PG8_STAGE(PG8_SB(1, 0), b3, voffB); PG8_STAGE(PG8_SB(1, 1), b3 + hstep, voffB); PG8_STAGE(PG8_SA(1, 0), a3, voffA);
            PG8_WAIT_V(8); PG8_WAIT_L(0); PG8_BAR; PG8_MMA(1, 0, At, B0); PG8_MMA(1, 1, At, B1); PG8_BAR; PG8_SCHED;
            } else {
            PG8_LDB(B0, 0, 0); PG8_SCHED; PG8_LDA(At, 0, 0); PG8_STAGE(PG8_SA(1, 1), a1 + hstep, voffA);
            PG8_WAIT_L(8); PG8_BAR; PG8_WAIT_L(0); PG8_MMA(0, 0, At, B0); PG8_BAR; PG8_SCHED;
            PG8_LDB(B1, 0, 1); PG8_STAGE(PG8_SB(0, 0), b2, voffB);
            PG8_BAR; PG8_WAIT_L(0); PG8_MMA(0, 1, At, B1); PG8_BAR;
            PG8_LDA(At, 0, 1); PG8_STAGE(PG8_SA(0, 0), a2, voffA);
            PG8_BAR; PG8_WAIT_L(0); PG8_MMA(1, 0, At, B0); PG8_BAR; PG8_SCHED;
            PG8_STAGE(PG8_SB(0, 1), b2 + hstep, voffB);
            PG8_WAIT_V(6); PG8_BAR; PG8_MMA(1, 1, At, B1); PG8_BAR;
            PG8_LDB(B0, 1, 0); PG8_SCHED; PG8_LDA(At, 1, 0); PG8_STAGE(PG8_SA(0, 1), a2 + hstep, voffA);
            PG8_WAIT_L(8); PG8_BAR; PG8_WAIT_L(0); PG8_MMA(0, 0, At, B0); PG8_BAR; PG8_SCHED;
            PG8_LDB(B1, 1, 1); PG8_STAGE(PG8_SB(1, 0), b3, voffB);
            PG8_BAR; PG8_WAIT_L(0); PG8_MMA(0, 1, At, B1); PG8_BAR;
            PG8_LDA(At, 1, 1); PG8_STAGE(PG8_SA(1, 0), a3, voffA);
            PG8_BAR; PG8_WAIT_L(0); PG8_MMA(1, 0, At, B0); PG8_BAR; PG8_SCHED;
            PG8_STAGE(PG8_SB(1, 1), b3 + hstep, voffB);
            PG8_WAIT_V(6); PG8_BAR; PG8_MMA(1, 1, At, B1); PG8_BAR;
            }
        }
        if constexpr (Hook::ENABLED) H(acc, nt, nt, ui, wr, fr);
        if constexpr (ALIGN_EPI) { if (wr == 0) PG8_BAR; }
        if constexpr (!Epi::AFTER_DRAIN) { E(acc, cur, wr, wc, fr, fq, ui); S.done(cur); }
        if (!has_next) break;
#pragma unroll
        for (int a = 0; a < 2; ++a)
#pragma unroll
            for (int b = 0; b < 2; ++b)
#pragma unroll
                for (int m = 0; m < 4; ++m)
#pragma unroll
                    for (int n = 0; n < 2; ++n) acc[a][b][m][n] = (f32x4){0.f, 0.f, 0.f, 0.f};
        cur = nxt; cA = nA; cB = nB; ++ui;
        if constexpr (ALIGN_EPI) { if (wr == 1) PG8_BAR; }
    }
    PG8_WAIT_V(0);
    if constexpr (!ALIGN_EPI) { if (wr == 0) PG8_BAR; }
    PG8_BAR;
    if constexpr (Epi::AFTER_DRAIN) { E.fused(acc, cur, wr, wc, fr, fq, lds, wid, lane); S.done(cur); }
#undef PG8_SA
#undef PG8_SB
#undef PG8_STAGE
#undef PG8_LDA
#undef PG8_LDB
#undef PG8_MMA
#undef PG8_WAIT_V
#undef PG8_WAIT_L
#undef PG8_BAR
#undef PG8_SCHED
}
}

typedef unsigned short bf16_t;
#define LAS __attribute__((address_space(3)))
typedef short bf16x8 __attribute__((ext_vector_type(8)));
typedef float f32x4 __attribute__((ext_vector_type(4)));
typedef float f32x16 __attribute__((ext_vector_type(16)));
typedef unsigned u32x4 __attribute__((ext_vector_type(4)));
typedef unsigned u32x2 __attribute__((ext_vector_type(2)));

constexpr int BATCH = 2, SEQ = 8192, DM = 2048, DEPTH = 4, MTOK = BATCH * SEQ, INW = 3840, DFF = 8192;
constexpr int QA_OFF = 0, KA_OFF = 512, VA_OFF = 640, QB_OFF = 768, KB_OFF = 1280, VB_OFF = 1792, QC_OFF = 2304, KC_OFF = 3328, VC_OFF = 3584;
constexpr int NVS = 14;
constexpr float LOG2E = 1.4426950408889634f;
constexpr float C2 = 0.125f * 1.4426950408889634f;
constexpr float EPS = 1e-6f;
constexpr float NEGBIG = -1e30f;

constexpr size_t SZ_WIN = (size_t)INW * DM * 2, SZ_WO = (size_t)DM * DM * 2, SZ_WUP = (size_t)DFF * DM * 2, SZ_WDN = (size_t)DM * DFF * 2;
constexpr size_t WS_WIN = 0;
constexpr size_t WS_WO = WS_WIN + DEPTH * SZ_WIN;
constexpr size_t WS_WUP = WS_WO + DEPTH * SZ_WO;
constexpr size_t WS_WDN = WS_WUP + DEPTH * SZ_WUP;
constexpr size_t WS_H = WS_WDN + DEPTH * SZ_WDN;
constexpr size_t WS_PROJ = WS_H + (size_t)MTOK * DM * 2;
constexpr size_t WS_VT = WS_PROJ + (size_t)MTOK * INW * 2;
constexpr size_t WS_O = WS_VT + (size_t)BATCH * NVS * 64 * SEQ * 2;
constexpr size_t WS_MIX = WS_O + (size_t)MTOK * DM * 2;
constexpr size_t WS_MIXEND = WS_MIX + (size_t)MTOK * DM * 2;
constexpr size_t WS_SS = WS_MIXEND;
constexpr size_t WS_SG = WS_SS + (size_t)(2 * DEPTH + 1) * MTOK * 8;
constexpr size_t WS_BAR = WS_SG + (size_t)DEPTH * 3 * MTOK * 8;
constexpr size_t WS_END = WS_BAR + 16384;
constexpr size_t WS_U = WS_PROJ;
static_assert(WS_U + (size_t)MTOK * DFF * 2 <= WS_MIXEND, "U overlay");
constexpr int LDS_BYTES = 147456;

struct Params {
    const float *x, *norm_mix, *w_in, *a_sink, *t5, *b_rpb, *c_q_gain, *c_k_gain, *og_a, *og_b, *og_c, *w_o, *norm_mlp, *w_up, *w_down, *norm_final;
    float* out; unsigned char* ws;
};
typedef const __attribute__((address_space(4))) Params* CP;
#define PP() ({ CP q_ = (CP)__builtin_amdgcn_kernarg_segment_ptr(); asm volatile("" : "+s"(q_)); q_; })

__device__ __forceinline__ float wave_sum(float v) {
#pragma unroll
    for (int o = 1; o < 64; o <<= 1) v += __shfl_xor(v, o);
    return v;
}
__device__ __forceinline__ unsigned pk_bf16(float lo, float hi) { return pg8::cvt_pk_bf16(lo, hi); }
__device__ __forceinline__ float bf_lo(unsigned w) { return __uint_as_float(w << 16); }
__device__ __forceinline__ float bf_hi(unsigned w) { return __uint_as_float(w & 0xffff0000u); }

constexpr int WI_IN = (DM / 64) * (INW / 32), WI_O = (DM / 64) * (DM / 32), WI_UP = (DM / 64) * (DFF / 32), WI_DN = (DFF / 64) * (DM / 32);
constexpr int W_PER_L = WI_IN + WI_O + WI_UP + WI_DN;
constexpr int W_DEFER = 6144;
struct WItem { const float* src; bf16_t* dst; const float* kg; int N, K; };
__device__ __forceinline__ void witem_desc(CP P, int l, int r, int lane, WItem& d) {
    unsigned char* ws = P->ws;
    const float* W; bf16_t* WT; const float* kgain; int K, N; bool permute = false;
    if (r < WI_IN) { W = P->w_in + (size_t)l * DM * INW; K = DM; N = INW; WT = (bf16_t*)(ws + WS_WIN + l * SZ_WIN); kgain = P->norm_mix + l * DM; permute = true; }
    else if ((r -= WI_IN) < WI_O) { W = P->w_o + (size_t)l * DM * DM; K = DM; N = DM; WT = (bf16_t*)(ws + WS_WO + l * SZ_WO);
        const int kk = 64 * (r / (DM / 32));
        kgain = kk < 512 ? P->og_a + l * 512 : kk < 1024 ? P->og_b + l * 512 - 512 : P->og_c + l * 1024 - 1024; }
    else if ((r -= WI_O) < WI_UP) { W = P->w_up + (size_t)l * DM * DFF; K = DM; N = DFF; WT = (bf16_t*)(ws + WS_WUP + l * SZ_WUP); kgain = P->norm_mlp + l * DM; }
    else { r -= WI_UP; W = P->w_down + (size_t)l * DFF * DM; K = DFF; N = DM; WT = (bf16_t*)(ws + WS_WDN + l * SZ_WDN); kgain = nullptr; }
    const int nblk = N / 32, kb = r / nblk, nb = r % nblk, k0 = 64 * kb, n0 = 32 * nb;
    const int d0 = permute ? (n0 & ~255) + 32 * (4 * (nb & 1) + ((nb & 7) >> 1)) : n0;
    const int g = lane & 7, nq = lane >> 3;
    d.src = W + (size_t)(k0 + 8 * g) * N + n0 + 4 * nq; d.dst = WT + (size_t)(d0 + 4 * nq) * K + k0 + 8 * g; d.kg = kgain ? kgain + k0 + 8 * g : nullptr; d.N = N; d.K = K;
}
__device__ __forceinline__ void witem_load(const WItem& d, f32x4 (&v)[8]) {
#pragma unroll
    for (int t = 0; t < 8; ++t) v[t] = __builtin_nontemporal_load((const f32x4*)(d.src + (size_t)t * d.N));
}
__device__ __forceinline__ void witem_finish(const WItem& d, f32x4 (&v)[8]) {
    if (d.kg) { const f32x4 g0 = *(const f32x4*)(d.kg), g1 = *(const f32x4*)(d.kg + 4);
#pragma unroll
        for (int t = 0; t < 4; ++t) { v[t] = v[t] * g0[t]; v[4 + t] = v[4 + t] * g1[t]; } }
#pragma unroll
    for (int j = 0; j < 4; ++j) { u32x4 o; o.x = pk_bf16(v[0][j], v[1][j]); o.y = pk_bf16(v[2][j], v[3][j]); o.z = pk_bf16(v[4][j], v[5][j]); o.w = pk_bf16(v[6][j], v[7][j]);
        __builtin_nontemporal_store(o, (u32x4*)(d.dst + (size_t)j * d.K)); }
}
template <class IDX>
__device__ __forceinline__ void weights_run(CP P, int total, int widx, int nw, int lane, const IDX& idx) {
    for (int it = widx; it < total; it += 2 * nw) {
        const bool two = it + nw < total;
        int la, ra, lb, rb; idx(it, la, ra); idx(two ? it + nw : it, lb, rb);
        WItem A, B; witem_desc(P, la, ra, lane, A); witem_desc(P, lb, rb, lane, B);
        f32x4 va[8], vb[8];
        witem_load(A, va); if (two) witem_load(B, vb);
        witem_finish(A, va); if (two) witem_finish(B, vb);
    }
}
constexpr int W_ATT_OWN = W_PER_L - WI_IN - W_DEFER;
static_assert(W_ATT_OWN + WI_IN <= 1024 * 16, "1024 A/B units x 8 waves x 2 items cover the attention-deferred list");
__device__ __forceinline__ bool witem_att(int layer, int i, int& l, int& r) {
    if (i < W_ATT_OWN) { l = layer; r = WI_IN + W_DEFER + i; return true; }
    if (layer + 1 < DEPTH && i < W_ATT_OWN + WI_IN) { l = layer + 1; r = i - W_ATT_OWN; return true; }
    return false;
}
__device__ __forceinline__ void weights_phase(CP P, LAS unsigned char* lds) {
    int tid_ = threadIdx.x; asm volatile("" : "+v"(tid_));
    const int lane = tid_ & 63, wave = __builtin_amdgcn_readfirstlane(tid_ >> 6);
    weights_run(P, WI_IN, blockIdx.x * 8 + wave, gridDim.x * 8, lane, [](int i, int& l, int& r) { l = 0; r = i; });
}
__device__ __forceinline__ void weights_deferred(CP P, int layer) {
    const int G = gridDim.x, c = blockIdx.x, rem = ((MTOK / 256) * (INW / 256)) % G;
    if (rem != 0 && c < rem) return;
    int tid_ = threadIdx.x; asm volatile("" : "+v"(tid_));
    const int lane = tid_ & 63, wave = __builtin_amdgcn_readfirstlane(tid_ >> 6);
    const int rank = rem ? c - rem : c, cnt = rem ? G - rem : G;
    weights_run(P, W_DEFER, rank * 8 + wave, cnt * 8, lane, [layer](int i, int& l, int& r) { l = layer; r = WI_IN + i; });
}

__device__ __forceinline__ void xinit_phase(const float* xin, bf16_t* xb, unsigned long long* ss) {
    int tid_ = threadIdx.x; asm volatile("" : "+v"(tid_));
    const int lane = tid_ & 63, wave = __builtin_amdgcn_readfirstlane(tid_ >> 6);
    const int gw = blockIdx.x * 8 + wave, NGW = gridDim.x * 8;
    for (int i = blockIdx.x * 512 + tid_; i < (2 * DEPTH + 3 * DEPTH) * MTOK; i += gridDim.x * 512) ss[MTOK + i] = 0ull;
    for (int row = gw; row < MTOK; row += NGW) {
        const f32x4* xr = (const f32x4*)(xin + (size_t)row * DM) + lane;
        u32x2* o = (u32x2*)(xb + (size_t)row * DM) + lane;
        float s = 0.f;
#pragma unroll
        for (int j = 0; j < 8; ++j) { const f32x4 v = xr[64 * j]; u32x2 w; w.x = pk_bf16(v.x, v.y); w.y = pk_bf16(v.z, v.w); o[64 * j] = w;
            const float a = bf_lo(w.x), b = bf_hi(w.x), c = bf_lo(w.y), d = bf_hi(w.y); s += (a * a + b * b) + (c * c + d * d); }
        s = wave_sum(s);
        if (lane == 0) ss[row] = (unsigned long long)(s * 16777216.f);
    }
}
__device__ __forceinline__ void final_phase(const bf16_t* xb, float* out, const float* gain, const unsigned long long* ss) {
    int tid_ = threadIdx.x; asm volatile("" : "+v"(tid_));
    const int lane = tid_ & 63, wave = __builtin_amdgcn_readfirstlane(tid_ >> 6);
    const int gw = blockIdx.x * 8 + wave, NGW = gridDim.x * 8;
    for (int row = gw; row < MTOK; row += NGW) {
        const u32x2* xr = (const u32x2*)(xb + (size_t)row * DM) + lane;
        f32x4* o = (f32x4*)(out + (size_t)row * DM) + lane;
        const float r = rsqrtf((float)ss[row] * (1.f / (DM * 16777216.f)) + EPS);
#pragma unroll
        for (int j = 0; j < 8; ++j) { const u32x2 w = xr[64 * j]; const f32x4 g = ((const f32x4*)gain)[lane + 64 * j];
            f32x4 v; v.x = bf_lo(w.x) * r * g.x; v.y = bf_hi(w.x) * r * g.y; v.z = bf_lo(w.y) * r * g.z; v.w = bf_hi(w.y) * r * g.w; o[64 * j] = v; }
    }
}

__device__ __forceinline__ constexpr float rope_freq(int i) {
    return i == 0 ? 1.f : i == 1 ? 0.5623413251903491f : i == 2 ? 0.31622776601683794f : i == 3 ? 0.1778279410038923f :
           i == 4 ? 0.1f : i == 5 ? 0.05623413251903491f : i == 6 ? 0.031622776601683794f : i == 7 ? 0.01778279410038923f :
           i == 8 ? 0.01f : i == 9 ? 0.005623413251903491f : i == 10 ? 0.0031622776601683794f : i == 11 ? 0.001778279410038923f :
           i == 12 ? 0.001f : i == 13 ? 0.0005623413251903491f : i == 14 ? 0.00031622776601683794f : 0.0001778279410038923f;
}
__device__ __forceinline__ void prep_phase(CP P, int layer) {
    int tid_ = threadIdx.x; asm volatile("" : "+v"(tid_));
    const int lane = tid_ & 63, wave = __builtin_amdgcn_readfirstlane(tid_ >> 6);
    const int gw = blockIdx.x * 8 + wave, NGW = gridDim.x * 8;
    bf16_t* proj = (bf16_t*)(P->ws + WS_PROJ); bf16_t* vt = (bf16_t*)(P->ws + WS_VT);
    for (int it = gw; it < 34 * (MTOK / 64); it += NGW) {
        const int slot = it % 34, tb = it / 34;
        const int tok = tb * 64 + lane, pos = tok & (SEQ - 1), b = tok >> 13;
        int col;
        if (slot < 16) col = QC_OFF + 64 * slot; else if (slot < 20) col = KC_OFF + 64 * (slot - 16);
        else if (slot < 22) col = VA_OFF + 64 * (slot - 20); else if (slot < 30) col = VB_OFF + 64 * (slot - 22); else col = VC_OFF + 64 * (slot - 30);
        u32x4* p = (u32x4*)(proj + (size_t)tok * INW + col);
        u32x4 raw[8];
#pragma unroll
        for (int j = 0; j < 8; ++j) raw[j] = p[j];
        if (slot < 20) {
            const float* gn = (slot < 16 ? P->c_q_gain : P->c_k_gain) + layer * 64;
            asm volatile("" : "+s"(gn));
            float ss = 0.f;
#pragma unroll
            for (int j = 0; j < 8; ++j)
#pragma unroll
                for (int q = 0; q < 4; ++q) { const float a = bf_lo(raw[j][q]), c = bf_hi(raw[j][q]); ss += a * a + c * c; }
            const float rr = rsqrtf(ss * (1.f / 64.f) + EPS) * ((slot < 16) ? C2 : 1.f);
            const float rowf = (float)(pos >> 6), colf = (float)(pos & 63);
            u32x4 outw[8];
#pragma unroll
            for (int i = 0; i < 16; i += 2) {
                const unsigned wa = raw[i >> 3][(i & 7) >> 1], wb = raw[(16 + i) >> 3][(i & 7) >> 1], wc = raw[(32 + i) >> 3][(i & 7) >> 1], wd = raw[(48 + i) >> 3][(i & 7) >> 1];
                float r1[2], r2[2], r3[2], r4[2];
#pragma unroll
                for (int e = 0; e < 2; ++e) {
                    const int d = i + e; const float f = rope_freq(d);
                    const float x1 = (e ? bf_hi(wa) : bf_lo(wa)) * rr * gn[d], x2 = (e ? bf_hi(wb) : bf_lo(wb)) * rr * gn[16 + d];
                    const float y1 = (e ? bf_hi(wc) : bf_lo(wc)) * rr * gn[32 + d], y2 = (e ? bf_hi(wd) : bf_lo(wd)) * rr * gn[48 + d];
                    const float ar = rowf * f, ac = colf * f;
                    const float cr = __cosf(ar), sr = __sinf(ar), cc = __cosf(ac), sc = __sinf(ac);
                    r1[e] = x1 * cr - x2 * sr; r2[e] = x2 * cr + x1 * sr; r3[e] = y1 * cc - y2 * sc; r4[e] = y2 * cc + y1 * sc;
                }
                outw[i >> 3][(i & 7) >> 1] = pk_bf16(r1[0], r1[1]); outw[(16 + i) >> 3][(i & 7) >> 1] = pk_bf16(r2[0], r2[1]);
                outw[(32 + i) >> 3][(i & 7) >> 1] = pk_bf16(r3[0], r3[1]); outw[(48 + i) >> 3][(i & 7) >> 1] = pk_bf16(r4[0], r4[1]);
                __builtin_amdgcn_sched_barrier(0);
            }
#pragma unroll
            for (int j = 0; j < 8; ++j) p[j] = outw[j];
        } else {
            const int vs = slot - 20;
            bf16_t* dst = vt + ((size_t)(b * NVS + vs) * 64) * SEQ + pos;
#pragma unroll
            for (int j = 0; j < 8; ++j)
#pragma unroll
                for (int q = 0; q < 4; ++q) { const unsigned w = raw[j][q]; dst[(size_t)(8 * j + 2 * q) * SEQ] = (bf16_t)(w & 0xffffu); dst[(size_t)(8 * j + 2 * q + 1) * SEQ] = (bf16_t)(w >> 16); }
        }
    }
}

constexpr int KP = 144;
constexpr int ATT_TILE = 64 * KP;
constexpr int ATT_K = 0, ATT_V = 2 * ATT_TILE, ATT_BIAS = 4 * ATT_TILE;
__device__ __forceinline__ float sq2(unsigned w) { const float a = bf_lo(w), b = bf_hi(w); return a * a + b * b; }
__device__ __forceinline__ int t5_bucket(int rel) {
    const int base = rel > 0 ? 16 : 0; const int n = rel < 0 ? -rel : rel; int v;
    if (n < 8) v = n; else if (n < 12) v = 8; else if (n < 16) v = 9; else if (n < 23) v = 10; else if (n < 32) v = 11;
    else if (n < 46) v = 12; else if (n < 64) v = 13; else if (n < 91) v = 14; else v = 15;
    return base + v;
}
__device__ __forceinline__ int clampi(int v, int lo, int hi) { return v < lo ? lo : (v > hi ? hi : v); }

template <int MODE>
__device__ __forceinline__ void attn_unit(LAS unsigned char* lds, const bf16_t* proj, const bf16_t* vt, bf16_t* obuf,
                                          int b, int hk, int blk, const float* btab, const float* sink, unsigned long long* sg, bool build_lut, CP WP, int wlayer, int wbase) {
    int tid_ = threadIdx.x; asm volatile("" : "+v"(tid_));
    const int tid = tid_, lane = tid & 63, r = lane & 31, h = lane >> 5;
    const int w = __builtin_amdgcn_readfirstlane(tid >> 6);
    WItem wiA, wiB; f32x4 wva[8], wvb[8]; bool whA = false, whB = false;
    int qhead, qpos, qcol, kcol, vslot, ocol, T0, T1, w0 = 0, w1 = 0, grow = 0;
    if (MODE == 0)      { qhead = 4 * hk + (w >> 1); qpos = blk * 64 + 32 * (w & 1) + r; qcol = QA_OFF + 64 * qhead; kcol = KA_OFF + 64 * hk; vslot = hk; ocol = 64 * qhead;
                          T0 = blk - 2 < 0 ? 0 : blk - 2; T1 = blk + 2 > 127 ? 127 : blk + 2; }
    else if (MODE == 2) { qhead = 4 * hk + (w >> 1); qpos = blk * 64 + 32 * (w & 1) + r; qcol = QC_OFF + 64 * qhead; kcol = KC_OFF + 64 * hk; vslot = 10 + hk; ocol = 1024 + 64 * qhead;
                          T0 = 0; T1 = 127; }
    else                { qhead = hk; qpos = blk * 256 + 32 * w + r; qcol = QB_OFF + 64 * hk; kcol = KB_OFF + 64 * hk; vslot = 2 + hk; ocol = 512 + 64 * hk;
                          grow = 4 * blk + (w >> 1); T0 = clampi(4 * blk - 4, 0, 120); T1 = clampi(4 * blk - 1, 0, 120) + 7; w0 = clampi(grow - 4, 0, 120); w1 = w0 + 7; }
    LAS float* bias = (LAS float*)(lds + ATT_BIAS);
    float pen0[16], pen1[16];
    if (MODE == 0 && build_lut) {
        for (int idx = tid; idx < 4 * 384; idx += 512) { const int hh = idx / 384, rel = idx % 384 - 192;
            bias[idx] = (rel >= -128 && rel <= 128) ? btab[t5_bucket(rel) * 8 + 4 * hk + hh] * LOG2E : NEGBIG; }
    } else if (MODE == 1) {
        for (int idx = tid; idx < 15 * 128; idx += 512) { const int dr = idx >> 7, y = idx & 127; bias[idx] = btab[(hk * 15 + dr) * 31 + clampi(y - 48, 0, 30)] * LOG2E; }
        const int c = 32 * (w & 1) + r, cs = clampi(c - 8, 0, 48);
#pragma unroll
        for (int i = 0; i < 16; ++i) { const int k0 = 16 * (i >> 3) + 8 * h + (i & 7), k1 = k0 + 32;
            pen0[i] = (k0 >= cs && k0 < cs + 16) ? 0.f : NEGBIG; pen1[i] = (k1 >= cs && k1 < cs + 16) ? 0.f : NEGBIG; }
    }
    const size_t tokbase = (size_t)b * SEQ;
    const int srow = tid >> 3, sch = tid & 7;
    const bf16_t* kg = proj + (tokbase + srow) * INW + kcol + sch * 8;
    const bf16_t* vg = vt + ((size_t)(b * NVS + vslot) * 64 + srow) * SEQ + sch * 8;
    const unsigned sdst = srow * KP + sch * 16;
    u32x4 kreg, vreg;
    const bf16_t* qg = proj + (tokbase + qpos) * INW + qcol + 8 * h;
    bf16x8 qf[4];
#pragma unroll
    for (int ks = 0; ks < 4; ++ks) qf[ks] = *(const bf16x8*)(qg + 16 * ks);
    float m = (MODE == 0) ? sink[qhead] * LOG2E : NEGBIG;
    float l = (MODE == 0 && h == 0) ? 1.f : 0.f;
    f32x16 o0, o1;
#pragma unroll
    for (int i = 0; i < 16; ++i) { o0[i] = 0.f; o1[i] = 0.f; }
    const int pr = (r & ~12) | ((r & 4) << 1) | ((r & 8) >> 1);
    const int nT = T1 - T0 + 1;
    kreg = *(const u32x4*)(kg + (size_t)(T0 * 64) * INW); vreg = *(const u32x4*)(vg + T0 * 64);
    *(LAS u32x4*)(lds + ATT_K + sdst) = kreg; *(LAS u32x4*)(lds + ATT_V + sdst) = vreg;
    __syncthreads();
    if (MODE != 2 && wlayer >= 0) { int l_, r_;
        whA = witem_att(wlayer, wbase + 2 * w, l_, r_); if (whA) { witem_desc(WP, l_, r_, lane, wiA); witem_load(wiA, wva); }
        whB = witem_att(wlayer, wbase + 2 * w + 1, l_, r_); if (whB) { witem_desc(WP, l_, r_, lane, wiB); witem_load(wiB, wvb); } }
    for (int it = 0; it < nT; ++it) {
        const int T = T0 + it, buf = it & 1;
        if (it + 1 < nT) { kreg = *(const u32x4*)(kg + (size_t)((T + 1) * 64) * INW); vreg = *(const u32x4*)(vg + (T + 1) * 64); }
        const bool active = (MODE != 1) || (T >= w0 && T <= w1);
        if (active) {
            const LAS unsigned char* kb = lds + ATT_K + buf * ATT_TILE + pr * KP + 16 * h;
            f32x16 s0, s1;
#pragma unroll
            for (int i = 0; i < 16; ++i) { s0[i] = 0.f; s1[i] = 0.f; }
#pragma unroll
            for (int ks = 0; ks < 4; ++ks) {
                const bf16x8 a0 = *(const LAS bf16x8*)(kb + 32 * ks);
                const bf16x8 a1 = *(const LAS bf16x8*)(kb + 32 * KP + 32 * ks);
                s0 = __builtin_amdgcn_mfma_f32_32x32x16_bf16(a0, qf[ks], s0, 0, 0, 0);
                s1 = __builtin_amdgcn_mfma_f32_32x32x16_bf16(a1, qf[ks], s1, 0, 0, 0);
            }
            if (MODE == 0) {
                const LAS float* bh = bias + (w >> 1) * 384 + (T * 64 - qpos + 192 + 8 * h);
#pragma unroll
                for (int i = 0; i < 16; ++i) { const int o_ = 16 * (i >> 3) + (i & 7);
                    s0[i] = s0[i] * C2 + bh[o_]; s1[i] = s1[i] * C2 + bh[o_ + 32]; }
            } else if (MODE == 1) {
                const LAS float* bh = bias + (T - grow + 7) * 128 + (63 - (32 * (w & 1) + r) + 8 * h);
#pragma unroll
                for (int i = 0; i < 16; ++i) { const int o_ = 16 * (i >> 3) + (i & 7);
                    s0[i] = (s0[i] * C2 + bh[o_]) + pen0[i]; s1[i] = (s1[i] * C2 + bh[o_ + 32]) + pen1[i]; }
            }
            float mx = fmaxf(s0[0], s1[0]);
#pragma unroll
            for (int i = 1; i < 16; ++i) mx = fmaxf(mx, fmaxf(s0[i], s1[i]));
            mx = fmaxf(mx, __shfl_xor(mx, 32));
            const float mnew = fmaxf(m, mx);
            const float alpha = __builtin_amdgcn_exp2f(m - mnew);
            m = mnew;
            float ps = 0.f;
#pragma unroll
            for (int i = 0; i < 16; ++i) { s0[i] = __builtin_amdgcn_exp2f(s0[i] - mnew); s1[i] = __builtin_amdgcn_exp2f(s1[i] - mnew); ps += s0[i] + s1[i]; }
            l = l * alpha + ps;
#pragma unroll
            for (int i = 0; i < 16; ++i) { o0[i] *= alpha; o1[i] *= alpha; }
            u32x4 pw[4];
#pragma unroll
            for (int q = 0; q < 4; ++q) { pw[0][q] = pk_bf16(s0[2 * q], s0[2 * q + 1]); pw[1][q] = pk_bf16(s0[8 + 2 * q], s0[8 + 2 * q + 1]);
                                          pw[2][q] = pk_bf16(s1[2 * q], s1[2 * q + 1]); pw[3][q] = pk_bf16(s1[8 + 2 * q], s1[8 + 2 * q + 1]); }
            const LAS unsigned char* vb = lds + ATT_V + buf * ATT_TILE + r * KP + 16 * h;
#pragma unroll
            for (int ks = 0; ks < 4; ++ks) {
                const bf16x8 a0 = *(const LAS bf16x8*)(vb + 32 * ks);
                const bf16x8 a1 = *(const LAS bf16x8*)(vb + 32 * KP + 32 * ks);
                const bf16x8 pf = __builtin_bit_cast(bf16x8, pw[ks]);
                o0 = __builtin_amdgcn_mfma_f32_32x32x16_bf16(a0, pf, o0, 0, 0, 0);
                o1 = __builtin_amdgcn_mfma_f32_32x32x16_bf16(a1, pf, o1, 0, 0, 0);
            }
        }
        if (it + 1 < nT) { *(LAS u32x4*)(lds + ATT_K + (buf ^ 1) * ATT_TILE + sdst) = kreg; *(LAS u32x4*)(lds + ATT_V + (buf ^ 1) * ATT_TILE + sdst) = vreg; }
        __syncthreads();
    }
    if (MODE != 2) { if (whA) witem_finish(wiA, wva); if (whB) witem_finish(wiB, wvb); }
    l += __shfl_xor(l, 32);
    const float inv = 1.f / l;
    bf16_t* og = obuf + (tokbase + qpos) * DM + ocol + 4 * h;
    float qs = 0.f;
#pragma unroll
    for (int g = 0; g < 4; ++g) {
        u32x2 a, c;
        a.x = pk_bf16(o0[4 * g] * inv, o0[4 * g + 1] * inv); a.y = pk_bf16(o0[4 * g + 2] * inv, o0[4 * g + 3] * inv);
        c.x = pk_bf16(o1[4 * g] * inv, o1[4 * g + 1] * inv); c.y = pk_bf16(o1[4 * g + 2] * inv, o1[4 * g + 3] * inv);
        *(u32x2*)(og + 8 * g) = a; *(u32x2*)(og + 32 + 8 * g) = c;
        qs += sq2(a.x) + sq2(a.y) + sq2(c.x) + sq2(c.y);
    }
    qs += __shfl_xor(qs, 32);
    if (h == 0) atomicAdd(sg + tokbase + qpos, (unsigned long long)(qs * 16777216.f));
}

__device__ __forceinline__ void attn_b_unit(LAS unsigned char* lds, const bf16_t* proj, const bf16_t* vt, bf16_t* obuf, int b, int hk, int blk, const float* btab, unsigned long long* sg, bool build_lut, CP WP, int wlayer, int wbase) {
    int tid_ = threadIdx.x; asm volatile("" : "+v"(tid_));
    const int tid = tid_, lane = tid & 63, r = lane & 31, h = lane >> 5;
    const int w = __builtin_amdgcn_readfirstlane(tid >> 6);
    WItem wiA, wiB; f32x4 wva[8], wvb[8]; bool whA = false, whB = false;
    const int R0 = 4 * blk, ra = R0 + 2 * (w >> 2), m = w & 3;
    const int rq = ra + (r >> 4), c = 16 * m + (r & 15), qpos = rq * 64 + c;
    const int kc0 = clampi(16 * m - 8, 0, 32);
    const int qcol = QB_OFF + 64 * hk, kcol = KB_OFF + 64 * hk, vslot = 2 + hk, ocol = 512 + 64 * hk;
    const int T0 = clampi(R0 - 4, 0, 120), T1 = clampi(R0 - 1, 0, 120) + 7;
    const int wlo = clampi(ra - 4, 0, 120), whi = clampi(ra - 3, 0, 120) + 7;
    const int rsq = clampi(rq - 4, 0, 120);
    LAS float* bias = (LAS float*)(lds + ATT_BIAS);
    if (build_lut) for (int idx = tid; idx < 16 * 128; idx += 512) { const int dr = idx >> 7, y = idx & 127; bias[idx] = dr < 15 ? btab[(hk * 15 + dr) * 31 + clampi(y - 48, 0, 30)] * LOG2E : NEGBIG; }
    float pen[16];
    { const int cs = clampi(c - 8, 0, 48);
#pragma unroll
      for (int i = 0; i < 16; ++i) { const int kc = kc0 + 16 * (i >> 3) + 8 * h + (i & 7); pen[i] = (kc >= cs && kc < cs + 16) ? 0.f : NEGBIG; } }
    const size_t tokbase = (size_t)b * SEQ;
    const int srow = tid >> 3, sch = tid & 7;
    const bf16_t* kg = proj + (tokbase + srow) * INW + kcol + sch * 8;
    const bf16_t* vg = vt + ((size_t)(b * NVS + vslot) * 64 + srow) * SEQ + sch * 8;
    const unsigned sdst = srow * KP + sch * 16;
    u32x4 kreg, vreg;
    const bf16_t* qg = proj + (tokbase + qpos) * INW + qcol + 8 * h;
    bf16x8 qf[4];
#pragma unroll
    for (int ks = 0; ks < 4; ++ks) qf[ks] = *(const bf16x8*)(qg + 16 * ks);
    float mrun = -1e29f, l = 0.f;
    f32x16 o0, o1;
#pragma unroll
    for (int i = 0; i < 16; ++i) { o0[i] = 0.f; o1[i] = 0.f; }
    const int pr = (r & ~12) | ((r & 4) << 1) | ((r & 8) >> 1);
    const int nT = T1 - T0 + 1;
    kreg = *(const u32x4*)(kg + (size_t)(T0 * 64) * INW); vreg = *(const u32x4*)(vg + T0 * 64);
    *(LAS u32x4*)(lds + ATT_K + sdst) = kreg; *(LAS u32x4*)(lds + ATT_V + sdst) = vreg;
    __syncthreads();
    if (wlayer >= 0) { int l_, r_;
        whA = witem_att(wlayer, wbase + 2 * w, l_, r_); if (whA) { witem_desc(WP, l_, r_, lane, wiA); witem_load(wiA, wva); }
        whB = witem_att(wlayer, wbase + 2 * w + 1, l_, r_); if (whB) { witem_desc(WP, l_, r_, lane, wiB); witem_load(wiB, wvb); } }
    for (int it = 0; it < nT; ++it) {
        const int T = T0 + it, buf = it & 1;
        if (it + 1 < nT) { kreg = *(const u32x4*)(kg + (size_t)((T + 1) * 64) * INW); vreg = *(const u32x4*)(vg + (T + 1) * 64); }
        if (T >= wlo && T <= whi) {
            const LAS unsigned char* kb = lds + ATT_K + buf * ATT_TILE + (kc0 + pr) * KP + 16 * h;
            f32x16 s0;
#pragma unroll
            for (int i = 0; i < 16; ++i) s0[i] = 0.f;
#pragma unroll
            for (int ks = 0; ks < 4; ++ks) s0 = __builtin_amdgcn_mfma_f32_32x32x16_bf16(*(const LAS bf16x8*)(kb + 32 * ks), qf[ks], s0, 0, 0, 0);
            const int dr = (T >= rsq && T < rsq + 8) ? T - rq + 7 : 15;
            const LAS float* bh = bias + dr * 128 + (kc0 + 8 * h - c + 63);
#pragma unroll
            for (int i = 0; i < 16; ++i) s0[i] = (s0[i] * C2 + bh[16 * (i >> 3) + (i & 7)]) + pen[i];
            float mx = s0[0];
#pragma unroll
            for (int i = 1; i < 16; ++i) mx = fmaxf(mx, s0[i]);
            mx = fmaxf(mx, __shfl_xor(mx, 32));
            const float mnew = fmaxf(mrun, mx);
            const float alpha = __builtin_amdgcn_exp2f(mrun - mnew);
            mrun = mnew;
            float ps = 0.f;
#pragma unroll
            for (int i = 0; i < 16; ++i) { s0[i] = __builtin_amdgcn_exp2f(s0[i] - mnew); ps += s0[i]; }
            l = l * alpha + ps;
#pragma unroll
            for (int i = 0; i < 16; ++i) { o0[i] *= alpha; o1[i] *= alpha; }
            u32x4 pw[2];
#pragma unroll
            for (int q = 0; q < 4; ++q) { pw[0][q] = pk_bf16(s0[2 * q], s0[2 * q + 1]); pw[1][q] = pk_bf16(s0[8 + 2 * q], s0[8 + 2 * q + 1]); }
            const LAS unsigned char* vb = lds + ATT_V + buf * ATT_TILE + r * KP + 2 * kc0 + 16 * h;
#pragma unroll
            for (int ks = 0; ks < 2; ++ks) {
                const bf16x8 a0 = *(const LAS bf16x8*)(vb + 32 * ks), a1 = *(const LAS bf16x8*)(vb + 32 * KP + 32 * ks);
                const bf16x8 pf = __builtin_bit_cast(bf16x8, pw[ks]);
                o0 = __builtin_amdgcn_mfma_f32_32x32x16_bf16(a0, pf, o0, 0, 0, 0);
                o1 = __builtin_amdgcn_mfma_f32_32x32x16_bf16(a1, pf, o1, 0, 0, 0);
            }
        }
        if (it + 1 < nT) { *(LAS u32x4*)(lds + ATT_K + (buf ^ 1) * ATT_TILE + sdst) = kreg; *(LAS u32x4*)(lds + ATT_V + (buf ^ 1) * ATT_TILE + sdst) = vreg; }
        __syncthreads();
    }
    if (whA) witem_finish(wiA, wva);
    if (whB) witem_finish(wiB, wvb);
    l += __shfl_xor(l, 32);
    const float inv = 1.f / l;
    bf16_t* og = obuf + (tokbase + qpos) * DM + ocol + 4 * h;
    float qs = 0.f;
#pragma unroll
    for (int g = 0; g < 4; ++g) {
        u32x2 a, cc;
        a.x = pk_bf16(o0[4 * g] * inv, o0[4 * g + 1] * inv); a.y = pk_bf16(o0[4 * g + 2] * inv, o0[4 * g + 3] * inv);
        cc.x = pk_bf16(o1[4 * g] * inv, o1[4 * g + 1] * inv); cc.y = pk_bf16(o1[4 * g + 2] * inv, o1[4 * g + 3] * inv);
        *(u32x2*)(og + 8 * g) = a; *(u32x2*)(og + 32 + 8 * g) = cc;
        qs += sq2(a.x) + sq2(a.y) + sq2(cc.x) + sq2(cc.y);
    }
    qs += __shfl_xor(qs, 32);
    if (h == 0) atomicAdd(sg + tokbase + qpos, (unsigned long long)(qs * 16777216.f));
}

__device__ __forceinline__ void attn_c_unit(LAS unsigned char* lds, const bf16_t* proj, const bf16_t* vt, bf16_t* obuf, int b, int hk, int blk, float mref, unsigned long long* sg) {
    int tid_ = threadIdx.x; asm volatile("" : "+v"(tid_));
    const int tid = tid_, lane = tid & 63, r = lane & 31, h = lane >> 5;
    const int w = __builtin_amdgcn_readfirstlane(tid >> 6);
    const int qhead = 4 * hk + (w >> 1), qpos = blk * 128 + 64 * (w & 1) + r, qcol = QC_OFF + 64 * qhead, kcol = KC_OFF + 64 * hk, vslot = 10 + hk, ocol = 1024 + 64 * qhead;
    const size_t tokbase = (size_t)b * SEQ;
    const int srow = tid >> 3, sch = tid & 7;
    const bf16_t* kg = proj + (tokbase + srow) * INW + kcol + sch * 8;
    const bf16_t* vg = vt + ((size_t)(b * NVS + vslot) * 64 + srow) * SEQ + sch * 8;
    const unsigned sdst = srow * KP + sch * 16;
    u32x4 kreg, vreg;
    const bf16_t* qg = proj + (tokbase + qpos) * INW + qcol + 8 * h;
    bf16x8 qf[2][4];
#pragma unroll
    for (int j = 0; j < 2; ++j)
#pragma unroll
        for (int ks = 0; ks < 4; ++ks) qf[j][ks] = *(const bf16x8*)(qg + (size_t)(32 * j) * INW + 16 * ks);
    f32x16 negm;
#pragma unroll
    for (int i = 0; i < 16; ++i) negm[i] = 0.f;
    float l0 = 0.f, l1 = 0.f;
    f32x16 o00, o01, o10, o11;
#pragma unroll
    for (int i = 0; i < 16; ++i) { o00[i] = 0.f; o01[i] = 0.f; o10[i] = 0.f; o11[i] = 0.f; }
    const int pr = (r & ~12) | ((r & 4) << 1) | ((r & 8) >> 1);
    constexpr int nT = SEQ / 64;
    constexpr int CK = 0, CV = 4 * ATT_TILE;
#pragma unroll
    for (int i = 0; i < 2; ++i) { kreg = *(const u32x4*)(kg + (size_t)(i * 64) * INW); vreg = *(const u32x4*)(vg + i * 64);
        *(LAS u32x4*)(lds + CK + i * ATT_TILE + sdst) = kreg; *(LAS u32x4*)(lds + CV + i * ATT_TILE + sdst) = vreg; }
    __syncthreads();
    for (int it = 0; it < nT; ++it) {
        const int buf = it & 3;
        if (it + 2 < nT) { kreg = *(const u32x4*)(kg + (size_t)((it + 2) * 64) * INW); vreg = *(const u32x4*)(vg + (it + 2) * 64); }
        const LAS unsigned char* kb = lds + CK + buf * ATT_TILE + pr * KP + 16 * h;
        f32x16 s00, s01, s10, s11;
        {
            const bf16x8 a0 = *(const LAS bf16x8*)(kb), a1 = *(const LAS bf16x8*)(kb + 32 * KP);
            s00 = __builtin_amdgcn_mfma_f32_32x32x16_bf16(a0, qf[0][0], negm, 0, 0, 0);
            s10 = __builtin_amdgcn_mfma_f32_32x32x16_bf16(a0, qf[1][0], negm, 0, 0, 0);
            s01 = __builtin_amdgcn_mfma_f32_32x32x16_bf16(a1, qf[0][0], negm, 0, 0, 0);
            s11 = __builtin_amdgcn_mfma_f32_32x32x16_bf16(a1, qf[1][0], negm, 0, 0, 0);
        }
#pragma unroll
        for (int ks = 1; ks < 4; ++ks) {
            const bf16x8 a0 = *(const LAS bf16x8*)(kb + 32 * ks), a1 = *(const LAS bf16x8*)(kb + 32 * KP + 32 * ks);
            s00 = __builtin_amdgcn_mfma_f32_32x32x16_bf16(a0, qf[0][ks], s00, 0, 0, 0);
            s10 = __builtin_amdgcn_mfma_f32_32x32x16_bf16(a0, qf[1][ks], s10, 0, 0, 0);
            s01 = __builtin_amdgcn_mfma_f32_32x32x16_bf16(a1, qf[0][ks], s01, 0, 0, 0);
            s11 = __builtin_amdgcn_mfma_f32_32x32x16_bf16(a1, qf[1][ks], s11, 0, 0, 0);
        }
        u32x4 pw0[4], pw1[4];
        {
            float ps = 0.f;
#pragma unroll
            for (int i = 0; i < 16; ++i) { s00[i] = __builtin_amdgcn_exp2f(s00[i]); s01[i] = __builtin_amdgcn_exp2f(s01[i]); ps += s00[i] + s01[i]; }
            l0 += ps;
#pragma unroll
            for (int q = 0; q < 4; ++q) { pw0[0][q] = pk_bf16(s00[2 * q], s00[2 * q + 1]); pw0[1][q] = pk_bf16(s00[8 + 2 * q], s00[8 + 2 * q + 1]);
                                          pw0[2][q] = pk_bf16(s01[2 * q], s01[2 * q + 1]); pw0[3][q] = pk_bf16(s01[8 + 2 * q], s01[8 + 2 * q + 1]); }
        }
        {
            float ps = 0.f;
#pragma unroll
            for (int i = 0; i < 16; ++i) { s10[i] = __builtin_amdgcn_exp2f(s10[i]); s11[i] = __builtin_amdgcn_exp2f(s11[i]); ps += s10[i] + s11[i]; }
            l1 += ps;
#pragma unroll
            for (int q = 0; q < 4; ++q) { pw1[0][q] = pk_bf16(s10[2 * q], s10[2 * q + 1]); pw1[1][q] = pk_bf16(s10[8 + 2 * q], s10[8 + 2 * q + 1]);
                                          pw1[2][q] = pk_bf16(s11[2 * q], s11[2 * q + 1]); pw1[3][q] = pk_bf16(s11[8 + 2 * q], s11[8 + 2 * q + 1]); }
        }
        const LAS unsigned char* vb = lds + CV + buf * ATT_TILE + r * KP + 16 * h;
#pragma unroll
        for (int ks = 0; ks < 4; ++ks) {
            const bf16x8 a0 = *(const LAS bf16x8*)(vb + 32 * ks), a1 = *(const LAS bf16x8*)(vb + 32 * KP + 32 * ks);
            const bf16x8 p0 = __builtin_bit_cast(bf16x8, pw0[ks]), p1 = __builtin_bit_cast(bf16x8, pw1[ks]);
            o00 = __builtin_amdgcn_mfma_f32_32x32x16_bf16(a0, p0, o00, 0, 0, 0);
            o10 = __builtin_amdgcn_mfma_f32_32x32x16_bf16(a0, p1, o10, 0, 0, 0);
            o01 = __builtin_amdgcn_mfma_f32_32x32x16_bf16(a1, p0, o01, 0, 0, 0);
            o11 = __builtin_amdgcn_mfma_f32_32x32x16_bf16(a1, p1, o11, 0, 0, 0);
        }
        if (it + 2 < nT) { *(LAS u32x4*)(lds + CK + (buf ^ 2) * ATT_TILE + sdst) = kreg; *(LAS u32x4*)(lds + CV + (buf ^ 2) * ATT_TILE + sdst) = vreg; }
        if (it & 1) __syncthreads();
    }
    l0 += __shfl_xor(l0, 32); l1 += __shfl_xor(l1, 32);
    const float inv0 = 1.f / l0, inv1 = 1.f / l1;
    bf16_t* og = obuf + (tokbase + qpos) * DM + ocol + 4 * h;
    float qs0 = 0.f, qs1 = 0.f;
#pragma unroll
    for (int g = 0; g < 4; ++g) {
        u32x2 a, c;
        a.x = pk_bf16(o00[4 * g] * inv0, o00[4 * g + 1] * inv0); a.y = pk_bf16(o00[4 * g + 2] * inv0, o00[4 * g + 3] * inv0);
        c.x = pk_bf16(o01[4 * g] * inv0, o01[4 * g + 1] * inv0); c.y = pk_bf16(o01[4 * g + 2] * inv0, o01[4 * g + 3] * inv0);
        *(u32x2*)(og + 8 * g) = a; *(u32x2*)(og + 32 + 8 * g) = c;
        qs0 += sq2(a.x) + sq2(a.y) + sq2(c.x) + sq2(c.y);
        a.x = pk_bf16(o10[4 * g] * inv1, o10[4 * g + 1] * inv1); a.y = pk_bf16(o10[4 * g + 2] * inv1, o10[4 * g + 3] * inv1);
        c.x = pk_bf16(o11[4 * g] * inv1, o11[4 * g + 1] * inv1); c.y = pk_bf16(o11[4 * g + 2] * inv1, o11[4 * g + 3] * inv1);
        *(u32x2*)(og + (size_t)32 * DM + 8 * g) = a; *(u32x2*)(og + (size_t)32 * DM + 32 + 8 * g) = c;
        qs1 += sq2(a.x) + sq2(a.y) + sq2(c.x) + sq2(c.y);
    }
    qs0 += __shfl_xor(qs0, 32); qs1 += __shfl_xor(qs1, 32);
    if (h == 0) { atomicAdd(sg + tokbase + qpos, (unsigned long long)(qs0 * 16777216.f)); atomicAdd(sg + tokbase + qpos + 32, (unsigned long long)(qs1 * 16777216.f)); }
}

__device__ __forceinline__ void attn_phase(CP P, LAS unsigned char* lds, int layer) {
    const bf16_t* proj = (const bf16_t*)(P->ws + WS_PROJ); const bf16_t* vt = (const bf16_t*)(P->ws + WS_VT); bf16_t* obuf = (bf16_t*)(P->ws + WS_O);
    const int G = gridDim.x;
    unsigned long long* sgA = (unsigned long long*)(P->ws + WS_SG) + (size_t)(3 * layer) * MTOK; unsigned long long* sgB = sgA + MTOK; unsigned long long* sgC = sgB + MTOK;
    {
        float gq = 0.f, gk = 0.f;
        for (int d = 0; d < 64; ++d) { gq = fmaxf(gq, fabsf(P->c_q_gain[layer * 64 + d])); gk = fmaxf(gk, fabsf(P->c_k_gain[layer * 64 + d])); }
        const float bound = 64.f * C2 * gq * gk;
        if (bound < 60.f) {
            for (int u = blockIdx.x; u < 8 * 64; u += G) attn_c_unit(lds, proj, vt, obuf, (u & 7) >> 2, u & 3, u >> 3, 0.f, sgC);
        } else {
            for (int u = blockIdx.x; u < 8 * 128; u += G) attn_unit<2>(lds, proj, vt, obuf, (u & 7) >> 2, u & 3, u >> 3, nullptr, nullptr, sgC, false, P, -1, 0);
        }
    }
    { int prev = -1; for (int u = blockIdx.x; u < 4 * 128; u += G) { attn_unit<0>(lds, proj, vt, obuf, (u & 3) >> 1, u & 1, u >> 2, P->t5, P->a_sink + layer * 8, sgA, (u & 1) != prev, P, layer, u * 16); prev = u & 1; } }
    { int prev = -1; for (int u = blockIdx.x; u < 16 * 32; u += G) { attn_b_unit(lds, proj, vt, obuf, (u & 15) >> 3, u & 7, u >> 4, P->b_rpb + (size_t)layer * 8 * 15 * 31, sgB, (u & 7) != prev, P, layer, (512 + u) * 16); prev = u & 7; } }
}

__device__ __forceinline__ void mixnorm_phase(CP P, int layer) {
    int tid_ = threadIdx.x; asm volatile("" : "+v"(tid_));
    const int lane = tid_ & 63, wave = __builtin_amdgcn_readfirstlane(tid_ >> 6);
    const int gw = blockIdx.x * 8 + wave, NGW = gridDim.x * 8;
    const bf16_t* obuf = (const bf16_t*)(P->ws + WS_O); bf16_t* mix = (bf16_t*)(P->ws + WS_MIX);
    f32x4 g[4][2];
#pragma unroll
    for (int j = 0; j < 4; ++j) {
        const float* gp = (j == 0) ? P->og_a + layer * 512 + lane * 8 : (j == 1) ? P->og_b + layer * 512 + lane * 8 : P->og_c + layer * 1024 + (j - 2) * 512 + lane * 8;
        g[j][0] = *(const f32x4*)gp; g[j][1] = *(const f32x4*)(gp + 4);
    }
    for (int tok = gw; tok < MTOK; tok += NGW) {
        const u32x4* src = (const u32x4*)(obuf + (size_t)tok * DM) + lane;
        float v[4][8]; float ss[4];
#pragma unroll
        for (int j = 0; j < 4; ++j) { const u32x4 raw = src[64 * j]; ss[j] = 0.f;
#pragma unroll
            for (int q = 0; q < 4; ++q) { v[j][2 * q] = bf_lo(raw[q]); v[j][2 * q + 1] = bf_hi(raw[q]); ss[j] += v[j][2 * q] * v[j][2 * q] + v[j][2 * q + 1] * v[j][2 * q + 1]; } }
        const float sa = wave_sum(ss[0]), sb = wave_sum(ss[1]), sc = wave_sum(ss[2] + ss[3]);
        float rs[4]; rs[0] = rsqrtf(sa * (1.f / 512.f) + EPS); rs[1] = rsqrtf(sb * (1.f / 512.f) + EPS); rs[2] = rsqrtf(sc * (1.f / 1024.f) + EPS); rs[3] = rs[2];
        u32x4* dst = (u32x4*)(mix + (size_t)tok * DM) + lane;
#pragma unroll
        for (int j = 0; j < 4; ++j) { u32x4 wv;
            wv.x = pk_bf16(v[j][0] * rs[j] * g[j][0].x, v[j][1] * rs[j] * g[j][0].y); wv.y = pk_bf16(v[j][2] * rs[j] * g[j][0].z, v[j][3] * rs[j] * g[j][0].w);
            wv.z = pk_bf16(v[j][4] * rs[j] * g[j][1].x, v[j][5] * rs[j] * g[j][1].y); wv.w = pk_bf16(v[j][6] * rs[j] * g[j][1].z, v[j][7] * rs[j] * g[j][1].w);
            dst[64 * j] = wv; }
    }
}

typedef unsigned v4u __attribute__((ext_vector_type(4)));
#define XB_TMO      128
#define XB_XCNT(j)  (256  + 64 * (j))
#define XB_XSUB(j)  (1280 + 64 * (j))
#define XB_XGEN(j)  (2304 + 64 * (j))
#define XB_TOP      3328
#define XB_TOPGEN   3392
#define XCD_BAR_WORDS 3456
#define XB_SPIN_CAP (1u << 22)

__device__ __forceinline__ unsigned xb_ld(unsigned* p)              { return __hip_atomic_load(p, __ATOMIC_RELAXED, __HIP_MEMORY_SCOPE_AGENT); }
__device__ __forceinline__ unsigned xb_add(unsigned* p, unsigned v) { return __hip_atomic_fetch_add(p, v, __ATOMIC_RELAXED, __HIP_MEMORY_SCOPE_AGENT); }
__device__ __forceinline__ unsigned xb_xcc_id() { return (unsigned)__builtin_amdgcn_s_getreg((3 << 11) | 20) & 0xFu; }
#define XB_SPIN(cond, bar) do { unsigned _sp = 0; while (cond) { __builtin_amdgcn_s_sleep(1); \
    if ((++_sp & 255u) == 0u) { if (xb_ld(&(bar)[XB_TMO])) break; if (_sp > XB_SPIN_CAP) { atomicAdd(&(bar)[XB_TMO], 1u); break; } } } } while (0)

struct XcdBarrier {
    unsigned* bar; unsigned x;
    volatile LAS unsigned* st;
};

__device__ __forceinline__ XcdBarrier xcd_barrier_post(unsigned* bar, volatile LAS unsigned* st) {
    XcdBarrier b; b.bar = bar; b.x = xb_xcc_id(); b.st = st;
    if (threadIdx.x == 0) (void)xb_add(&bar[XB_XCNT(b.x)], 1u);
    return b;
}
__device__ __forceinline__ void xcd_barrier_complete(unsigned* bar, unsigned x, unsigned& nloc, unsigned& nx) {
    const unsigned G = gridDim.x * gridDim.y * gridDim.z;
    unsigned sum, cnt, mine, sp = 0u;
    for (;;) {
        sum = 0u; cnt = 0u; mine = 0u;
#pragma unroll
        for (unsigned j = 0; j < 16; ++j) { const unsigned c = xb_ld(&bar[XB_XCNT(j)]); sum += c; cnt += (c > 0u) ? 1u : 0u; mine = (j == x) ? c : mine; }
        if (sum == G) break;
        __builtin_amdgcn_s_sleep(1);
        if ((++sp & 255u) == 0u) { if (xb_ld(&bar[XB_TMO])) break; if (sp > XB_SPIN_CAP) { atomicAdd(&bar[XB_TMO], 1u); break; } }
    }
    nloc = mine > 0u ? mine : 1u; nx = cnt > 0u ? cnt : 1u;
}

__device__ __forceinline__ void xcd_barrier(const XcdBarrier& b) {
    asm volatile("s_waitcnt vmcnt(0)" ::: "memory");
    __syncthreads();
    if (threadIdx.x == 0) {
        unsigned* bar = b.bar;
        __builtin_amdgcn_s_waitcnt(0);
        unsigned nloc = b.st[0], nx = b.st[1];
        if (nloc == 0u) { xcd_barrier_complete(bar, b.x, nloc, nx); b.st[0] = nloc; b.st[1] = nx; }
        const unsigned old = xb_add(&bar[XB_XSUB(b.x)], 1u);
        const unsigned gen = old / nloc;
        if (old + 1u == (gen + 1u) * nloc) {
            __builtin_amdgcn_fence(__ATOMIC_RELEASE, "agent");
            asm volatile("s_waitcnt vmcnt(0)" ::: "memory");
            const unsigned og = xb_add(&bar[XB_TOP], 1u);
            const unsigned tg = og / nx;
            if (og + 1u == (tg + 1u) * nx) xb_add(&bar[XB_TOPGEN], 1u);
            else XB_SPIN(xb_ld(&bar[XB_TOPGEN]) == tg, bar);
            __builtin_amdgcn_fence(__ATOMIC_ACQUIRE, "agent");
            xb_add(&bar[XB_XGEN(b.x)], 1u);
            asm volatile("s_waitcnt vmcnt(0)" ::: "memory");
        } else {
            XB_SPIN(xb_ld(&bar[XB_XGEN(b.x)]) == gen, bar);
            __builtin_amdgcn_fence(__ATOMIC_ACQUIRE, "agent");
            asm volatile("s_waitcnt vmcnt(0)" ::: "memory");
        }
    }
    __syncthreads();
}

__global__ void __launch_bounds__(512, 2) hymba_fwd(Params Parg) {
    extern __shared__ __attribute__((aligned(16))) unsigned char lds_raw[];
    LAS unsigned char* lds = (LAS unsigned char*)lds_raw;
    cg::grid_group grid = cg::this_grid();
    volatile LAS unsigned* bar_st = (volatile LAS unsigned*)(lds + LDS_BYTES - 64);
    if (threadIdx.x < 2) bar_st[threadIdx.x] = 0u;
    __syncthreads();
    (void)xcd_barrier_post((unsigned*)(PP()->ws + WS_BAR), bar_st);
#define BUILD_RSTAB(S_, ssptr) do { pg8::Unit uu_; LAS float* t_ = (LAS float*)(lds + 131072); int tb_ = threadIdx.x; asm volatile("" : "+v"(tb_)); \
        _Pragma("unroll 1") for (int ui_ = 0; ui_ < 15 && (S_).next(ui_, uu_); ++ui_) \
            for (int rl_ = tb_; rl_ < 256; rl_ += 512) t_[ui_ * 256 + rl_] = rsqrtf((float)(ssptr)[(size_t)uu_.pm * 256 + rl_] * (1.f / (2048.f * 16777216.f)) + EPS); \
        __syncthreads(); } while (0)
#define GRID_BAR() do { XcdBarrier b_; b_.bar = (unsigned*)(PP()->ws + WS_BAR); b_.x = xb_xcc_id(); b_.st = bar_st; xcd_barrier(b_); } while (0)

    weights_phase(PP(), lds);
    { CP P = PP(); xinit_phase(P->x, (bf16_t*)(P->ws + WS_H), (unsigned long long*)(P->ws + WS_SS)); }
    grid.sync();
    for (int layer = 0; layer < DEPTH; ++layer) {
        {
            CP P = PP(); unsigned char* ws = P->ws;
            pg8::Gemm g{(const bf16_t*)(ws + WS_H), (const bf16_t*)(ws + WS_WIN + layer * SZ_WIN), MTOK, INW, DM}; pg8::StaticOrder S; S.init(MTOK, INW, gridDim.x, blockIdx.x);
            BUILD_RSTAB(S, (const unsigned long long*)(ws + WS_SS) + (size_t)(2 * layer) * MTOK);
            pg8::EpiInProj E{(bf16_t*)(ws + WS_PROJ), (bf16_t*)(ws + WS_VT), (const LAS float*)(lds + 131072), P->c_q_gain + layer * 64, P->c_k_gain + layer * 64};
            pg8::gemm_phase<pg8::EpiInProj, pg8::StaticOrder, true, true>(lds, g, S, E);
        }
        weights_deferred(PP(), layer);
        GRID_BAR();
        attn_phase(PP(), lds, layer);
        GRID_BAR();
        {
            CP P = PP(); unsigned char* ws = P->ws;
            pg8::Gemm g{(const bf16_t*)(ws + WS_O), (const bf16_t*)(ws + WS_WO + layer * SZ_WO), MTOK, DM, DM}; pg8::StaticOrder S; S.init(MTOK, DM, gridDim.x, blockIdx.x);
            LAS float* tab = (LAS float*)(lds + 131072);
            {
                const unsigned long long* sgA = (const unsigned long long*)(ws + WS_SG) + (size_t)(3 * layer) * MTOK;
                pg8::Unit uu;
                int tb_ = threadIdx.x; asm volatile("" : "+v"(tb_));
#pragma unroll 1
                for (int ui = 0; ui < 4 && S.next(ui, uu); ++ui)
                    for (int rl = tb_; rl < 256; rl += 512) { const size_t tok = (size_t)uu.pm * 256 + rl;
                        const float ra = rsqrtf((float)sgA[tok] * (1.f / (512.f * 16777216.f)) + EPS), rb = rsqrtf((float)sgA[MTOK + tok] * (1.f / (512.f * 16777216.f)) + EPS),
                                    rc = rsqrtf((float)sgA[2 * MTOK + tok] * (1.f / (1024.f * 16777216.f)) + EPS);
                        tab[(ui * 3 + 0) * 256 + rl] = ra / rb; tab[(ui * 3 + 1) * 256 + rl] = rb / rc; tab[(ui * 3 + 2) * 256 + rl] = rc; }
                __syncthreads();
            }
            pg8::EpiResBf16 E{(bf16_t*)(ws + WS_H), DM, (unsigned long long*)(ws + WS_SS) + (size_t)(2 * layer + 1) * MTOK};
            pg8::MixHook Hk{tab};
            pg8::gemm_phase<pg8::EpiResBf16, pg8::StaticOrder, true, true, pg8::MixHook>(lds, g, S, E, Hk);
        }
        GRID_BAR();
        {
            CP P = PP(); unsigned char* ws = P->ws;
            pg8::Gemm g{(const bf16_t*)(ws + WS_H), (const bf16_t*)(ws + WS_WUP + layer * SZ_WUP), MTOK, DFF, DM}; pg8::StaticOrder S; S.init(MTOK, DFF, gridDim.x, blockIdx.x);
            BUILD_RSTAB(S, (const unsigned long long*)(ws + WS_SS) + (size_t)(2 * layer + 1) * MTOK);
            pg8::EpiBf16<2> E{(bf16_t*)(ws + WS_U), DFF, (const LAS float*)(lds + 131072)};
            pg8::gemm_phase<pg8::EpiBf16<2>, pg8::StaticOrder, true, true>(lds, g, S, E);
        }
        GRID_BAR();
        {
            CP P = PP(); unsigned char* ws = P->ws;
            pg8::Gemm g{(const bf16_t*)(ws + WS_U), (const bf16_t*)(ws + WS_WDN + layer * SZ_WDN), MTOK, DM, DFF}; pg8::StaticOrder S; S.init(MTOK, DM, gridDim.x, blockIdx.x);
            pg8::EpiResBf16 E{(bf16_t*)(ws + WS_H), DM, (unsigned long long*)(ws + WS_SS) + (size_t)(2 * layer + 2) * MTOK};
            pg8::gemm_phase<pg8::EpiResBf16, pg8::StaticOrder, true, true, pg8::NoHook, true>(lds, g, S, E);
        }
        GRID_BAR();
    }
    { CP P = PP(); final_phase((const bf16_t*)(P->ws + WS_H), P->out, P->norm_final, (const unsigned long long*)(P->ws + WS_SS) + (size_t)(2 * DEPTH) * MTOK); }
}

extern "C" void kernel_launch(void* const* d_in, const int* in_sizes, int n_in, void* d_out, int out_size, void* d_ws, size_t ws_size, hipStream_t stream) {
    static int grid = 0;
    if (grid == 0) {
        if (n_in != 16 || in_sizes[0] != MTOK * DM || out_size != MTOK * DM || ws_size < WS_END) {
            fprintf(stderr, "kernel_launch: unexpected shapes (n_in %d, in0 %d, out %d, ws %zu need %zu)\n", n_in, n_in > 0 ? in_sizes[0] : -1, out_size, ws_size, (size_t)WS_END); grid = -1; return; }
        int dev = 0, cus = 0, per_cu = 0;
        hipGetDevice(&dev); hipDeviceGetAttribute(&cus, hipDeviceAttributeMultiprocessorCount, dev);
        if (hipFuncSetAttribute((const void*)hymba_fwd, hipFuncAttributeMaxDynamicSharedMemorySize, LDS_BYTES) != hipSuccess) fprintf(stderr, "kernel_launch: hipFuncSetAttribute failed\n");
        if (hipOccupancyMaxActiveBlocksPerMultiprocessor(&per_cu, (const void*)hymba_fwd, 512, LDS_BYTES) != hipSuccess || per_cu < 1) { fprintf(stderr, "kernel_launch: occupancy query gave %d\n", per_cu); per_cu = 1; }
        (void)hipGetLastError();
        grid = cus * per_cu;
        if (grid < 192) { fprintf(stderr, "kernel_launch: grid %d too small for this build (the LDS row-factor tables hold 4 out-projection / 15 up-projection tiles per workgroup)\n", grid); grid = -1; return; }
    }
    if (grid < 0) return;
    Params p{};
    p.x = (const float*)d_in[0]; p.norm_mix = (const float*)d_in[1]; p.w_in = (const float*)d_in[2]; p.a_sink = (const float*)d_in[3]; p.t5 = (const float*)d_in[4];
    p.b_rpb = (const float*)d_in[5]; p.c_q_gain = (const float*)d_in[6]; p.c_k_gain = (const float*)d_in[7]; p.og_a = (const float*)d_in[8]; p.og_b = (const float*)d_in[9];
    p.og_c = (const float*)d_in[10]; p.w_o = (const float*)d_in[11]; p.norm_mlp = (const float*)d_in[12]; p.w_up = (const float*)d_in[13]; p.w_down = (const float*)d_in[14];
    p.norm_final = (const float*)d_in[15]; p.out = (float*)d_out; p.ws = (unsigned char*)d_ws;
    if (hipMemsetAsync((char*)d_ws + WS_BAR, 0, 16384, stream) != hipSuccess) { fprintf(stderr, "kernel_launch: memset of the barrier words failed\n"); return; }
    void* args[] = {&p};
    hipError_t e = hipLaunchCooperativeKernel((const void*)hymba_fwd, dim3(grid), dim3(512), args, LDS_BYTES, stream);
    if (e != hipSuccess) fprintf(stderr, "kernel_launch: cooperative launch failed: %s (grid %d)\n", hipGetErrorString(e), grid);
}
```
